# Optimizing an MI355X kernel written in HIP

```python
import jax, jax.numpy as jnp
from jax import lax
import numpy as np

D_MODEL = 1024
BATCH = 8
SEQ = 2048
DEPTH = 2

CTX_LEN = 256
GRID_W = 64
ROPE_BASE = 10000.0
NORM_EPS = 1e-6
NEG_INF = -1e30

A_HEADS = 8
A_KV_HEADS = 2
A_HEAD_DIM = 64
A_WIDTH = A_HEADS * A_HEAD_DIM
A_KV_WIDTH = A_KV_HEADS * A_HEAD_DIM
WINDOW = 128
A_BLOCK = 128
B_GROUPS = 8
B_WIDTH = D_MODEL // 2
B_GROUP_DIM = B_WIDTH // B_GROUPS
CHUNK = 128
EVEN_MIX = A_WIDTH + B_WIDTH
EVEN_SPLITS = [A_WIDTH, A_WIDTH + A_KV_WIDTH, A_WIDTH + 2 * A_KV_WIDTH,
               A_WIDTH + 2 * A_KV_WIDTH + B_WIDTH, A_WIDTH + 2 * A_KV_WIDTH + 2 * B_WIDTH]
EVEN_IN = A_WIDTH + 2 * A_KV_WIDTH + 2 * B_WIDTH + EVEN_MIX

C_HEADS = 16
C_NOPE = 64
C_ROPE = 32
C_V = 64
Q_RANK = 256
KV_RANK = 128
C_WIDTH = C_HEADS * C_V
ODD_SPLITS = [Q_RANK, Q_RANK + KV_RANK, Q_RANK + KV_RANK + C_ROPE]
ODD_IN = Q_RANK + KV_RANK + C_ROPE + C_WIDTH
Q_BLOCK = 128

N_EVEN = (DEPTH + 1) // 2
N_ODD = DEPTH // 2

kernel_name = 'hybrid_dit_window_gmlp_mla'


def rms_norm(x, g):
    xf = x.astype(jnp.float32)
    y = xf * lax.rsqrt(jnp.mean(xf * xf, axis=-1, keepdims=True) + NORM_EPS)
    return (y * g.astype(jnp.float32)).astype(x.dtype)


def layer_norm(x, g, b):
    xf = x.astype(jnp.float32)
    mu = jnp.mean(xf, axis=-1, keepdims=True)
    xc = xf - mu
    y = xc * lax.rsqrt(jnp.mean(xc * xc, axis=-1, keepdims=True) + NORM_EPS)
    return (y * g.astype(jnp.float32) + b.astype(jnp.float32)).astype(x.dtype)


def grid_positions(n):
    rows = n // GRID_W
    row = jnp.broadcast_to(jnp.arange(rows, dtype=jnp.float32)[:, None], (rows, GRID_W)).reshape(-1)
    col = jnp.broadcast_to(jnp.arange(GRID_W, dtype=jnp.float32)[None, :], (rows, GRID_W)).reshape(-1)
    return row, col


def rope_1d(x, pos):
    half = x.shape[-1] // 2
    inv = ROPE_BASE ** (-jnp.arange(half, dtype=jnp.float32) / half)
    ang = pos[:, None] * inv[None, :]
    cos = jnp.cos(ang)[None, :, None, :]
    sin = jnp.sin(ang)[None, :, None, :]
    x1, x2 = x[..., :half], x[..., half:]
    return jnp.concatenate([x1 * cos - x2 * sin, x1 * sin + x2 * cos], axis=-1)


def rope_2d(x, row, col):
    d = x.shape[-1] // 2
    xf = x.astype(jnp.float32)
    out = jnp.concatenate([rope_1d(xf[..., :d], row), rope_1d(xf[..., d:], col)], axis=-1)
    return out.astype(x.dtype)


def windowed_sink_gqa(q, k, v, kc, vc, sink):
    B_, S, Hq, Dh = q.shape
    Hkv = k.shape[2]
    G = Hq // Hkv
    blk = A_BLOCK
    nb = S // blk
    C = kc.shape[1]
    scale = Dh ** -0.5
    qb = q.reshape(B_, nb, blk, Hkv, G, Dh)
    pad = ((0, 0), (blk, blk), (0, 0), (0, 0))
    kp = jnp.pad(k, pad).reshape(B_, nb + 2, blk, Hkv, Dh)
    vp = jnp.pad(v, pad).reshape(B_, nb + 2, blk, Hkv, Dh)
    kb = jnp.concatenate([kp[:, :-2], kp[:, 1:-1], kp[:, 2:]], axis=2)
    vb = jnp.concatenate([vp[:, :-2], vp[:, 1:-1], vp[:, 2:]], axis=2)
    qi = jnp.arange(nb)[:, None, None] * blk + jnp.arange(blk)[None, :, None]
    kj = jnp.arange(nb)[:, None, None] * blk - blk + jnp.arange(3 * blk)[None, None, :]
    valid = (jnp.abs(qi - kj) <= WINDOW) & (kj >= 0) & (kj < S)
    s_loc = jnp.einsum('bnqhgd,bnkhd->bhgnqk', qb, kb).astype(jnp.float32) * scale
    s_loc = jnp.where(valid, s_loc, NEG_INF)
    s_ctx = jnp.einsum('bnqhgd,bchd->bhgnqc', qb, kc).astype(jnp.float32) * scale
    s_sink = jnp.broadcast_to(sink.astype(jnp.float32).reshape(1, Hkv, G, 1, 1, 1), s_loc.shape[:-1] + (1,))
    p = jax.nn.softmax(jnp.concatenate([s_loc, s_ctx, s_sink], axis=-1), axis=-1).astype(v.dtype)
    nk = 3 * blk
    o = (jnp.einsum('bhgnqk,bnkhd->bnqhgd', p[..., :nk], vb)
         + jnp.einsum('bhgnqc,bchd->bnqhgd', p[..., nk:nk + C], vc))
    return o.reshape(B_, S, Hq * Dh)


def context_sink_gqa(qc, kc, vc, sink):
    B_, C, Hq, Dh = qc.shape
    Hkv = kc.shape[2]
    G = Hq // Hkv
    scale = Dh ** -0.5
    qg = qc.reshape(B_, C, Hkv, G, Dh)
    s = jnp.einsum('bqhgd,bkhd->bhgqk', qg, kc).astype(jnp.float32) * scale
    s_sink = jnp.broadcast_to(sink.astype(jnp.float32).reshape(1, Hkv, G, 1, 1), s.shape[:-1] + (1,))
    p = jax.nn.softmax(jnp.concatenate([s, s_sink], axis=-1), axis=-1)[..., :C].astype(vc.dtype)
    return jnp.einsum('bhgqk,bkhd->bqhgd', p, vc).reshape(B_, C, Hq * Dh)


def chunk_gmlp(u, v, ln_g, ln_b, w_s, b_s):
    B_, L, _ = v.shape
    n = L // CHUNK
    vn = layer_norm(v, ln_g, ln_b).reshape(B_, n, CHUNK, B_GROUPS, B_GROUP_DIM)
    s = jnp.einsum('gpq,bnqgc->bnpgc', w_s, vn) + jnp.transpose(b_s)[None, None, :, :, None]
    return u * s.reshape(B_, L, B_WIDTH)


def even_layer(hl, hc, w_in, sink, ln_g, ln_b, w_s, b_s, w_out, row, col, need_ctx):
    B_, S, _ = hl.shape
    C = hc.shape[1]
    gelu = lambda t: jax.nn.gelu(t, approximate=False)
    q, k, v, u, vv, gate = jnp.split(hl @ w_in, EVEN_SPLITS, axis=-1)
    q = rope_2d(q.reshape(B_, S, A_HEADS, A_HEAD_DIM), row, col)
    k = rope_2d(k.reshape(B_, S, A_KV_HEADS, A_HEAD_DIM), row, col)
    v = v.reshape(B_, S, A_KV_HEADS, A_HEAD_DIM)
    if need_ctx:
        qc, kc, vc, uc, vvc, gate_c = jnp.split(hc @ w_in, EVEN_SPLITS, axis=-1)
    else:
        kc, vc = jnp.split(hc @ w_in[:, A_WIDTH:A_WIDTH + 2 * A_KV_WIDTH], 2, axis=-1)
    kc = kc.reshape(B_, C, A_KV_HEADS, A_HEAD_DIM)
    vc = vc.reshape(B_, C, A_KV_HEADS, A_HEAD_DIM)
    a = windowed_sink_gqa(q, k, v, kc, vc, sink)
    b = chunk_gmlp(gelu(u), gelu(vv), ln_g, ln_b, w_s, b_s)
    y = (jnp.concatenate([a, b], axis=-1) * jax.nn.silu(gate)) @ w_out
    if need_ctx:
        ac = context_sink_gqa(qc.reshape(B_, C, A_HEADS, A_HEAD_DIM), kc, vc, sink)
        bc = chunk_gmlp(gelu(uc), gelu(vvc), ln_g, ln_b, w_s, b_s)
        yc = (jnp.concatenate([ac, bc], axis=-1) * jax.nn.silu(gate_c)) @ w_out
    else:
        yc = None
    return y, yc


def mla_queries(q_a, q_norm, w_qb, row, col):
    B_, L, _ = q_a.shape
    q = (rms_norm(q_a, q_norm) @ w_qb).reshape(B_, L, C_HEADS, C_NOPE + C_ROPE)
    q_nope, q_pe = q[..., :C_NOPE], q[..., C_NOPE:]
    if row is not None:
        q_pe = rope_2d(q_pe, row, col)
    return jnp.concatenate([q_nope, q_pe], axis=-1)


def mla_keys_values(kv_a, k_pe, kv_norm, w_kvb, row, col):
    B_, L, _ = kv_a.shape
    kv = (rms_norm(kv_a, kv_norm) @ w_kvb).reshape(B_, L, C_HEADS, C_NOPE + C_V)
    k_nope, v = kv[..., :C_NOPE], kv[..., C_NOPE:]
    k_pe = k_pe[:, :, None, :]
    if row is not None:
        k_pe = rope_2d(k_pe, row, col)
    k = jnp.concatenate([k_nope, jnp.broadcast_to(k_pe, (B_, L, C_HEADS, C_ROPE))], axis=-1)
    return k, v


def block_attention(q, k, v):
    B_, Lq, H, dk = q.shape
    nb = Lq // Q_BLOCK
    scale = dk ** -0.5
    qb = jnp.moveaxis(q.reshape(B_, nb, Q_BLOCK, H, dk), 1, 0)

    def one(qblk):
        s = jnp.einsum('bqhd,bkhd->bhqk', qblk, k).astype(jnp.float32) * scale
        p = jax.nn.softmax(s, axis=-1).astype(v.dtype)
        return jnp.einsum('bhqk,bkhd->bqhd', p, v)

    o = lax.map(one, qb)
    return jnp.moveaxis(o, 0, 1).reshape(B_, Lq, H * v.shape[-1])


def odd_layer(hl, hc, w_in, q_norm, w_qb, kv_norm, w_kvb, w_out, row, col, need_ctx):
    q_a, kv_a, k_pe, gate = jnp.split(hl @ w_in, ODD_SPLITS, axis=-1)
    q = mla_queries(q_a, q_norm, w_qb, row, col)
    k, v = mla_keys_values(kv_a, k_pe, kv_norm, w_kvb, row, col)
    if need_ctx:
        q_ac, kv_ac, k_pec, gate_c = jnp.split(hc @ w_in, ODD_SPLITS, axis=-1)
    else:
        kv_ac, k_pec = jnp.split(hc @ w_in[:, Q_RANK:Q_RANK + KV_RANK + C_ROPE], [KV_RANK], axis=-1)
    kc, vc = mla_keys_values(kv_ac, k_pec, kv_norm, w_kvb, None, None)
    o = block_attention(q, jnp.concatenate([k, kc], axis=1), jnp.concatenate([v, vc], axis=1))
    y = (o * jax.nn.silu(gate)) @ w_out
    if need_ctx:
        qc = mla_queries(q_ac, q_norm, w_qb, None, None)
        oc = block_attention(qc, kc, vc)
        yc = (oc * jax.nn.silu(gate_c)) @ w_out
    else:
        yc = None
    return y, yc


def setup_inputs(seed: int = 0) -> dict:
    key = jax.random.key(seed)
    ks = jax.random.split(key, 24)
    f32 = jnp.float32

    def nrm(k, shape, s=1.0):
        return jax.random.normal(k, shape, f32) * s

    def w(k, shape, fan_in, g=1.0):
        return nrm(k, shape, g * fan_in ** -0.5)

    def gain(k, shape):
        return 1.0 + nrm(k, shape, 0.05)

    return {
        'x': nrm(ks[0], (BATCH, SEQ, D_MODEL)),
        'c': nrm(ks[1], (BATCH, D_MODEL)),
        'ctx': nrm(ks[2], (BATCH, CTX_LEN, D_MODEL)),
        'c_ctx': nrm(ks[3], (D_MODEL,)),
        'norm_g': gain(ks[4], (DEPTH, D_MODEL)),
        'w_ada': w(ks[5], (DEPTH, D_MODEL, 3 * D_MODEL), D_MODEL, 0.5),
        'b_ada': nrm(ks[6], (DEPTH, 3 * D_MODEL), 0.02),
        'w_in0': w(ks[7], (N_EVEN, D_MODEL, EVEN_IN), D_MODEL),
        'sink0': nrm(ks[8], (N_EVEN, A_HEADS), 0.5),
        'gm_ln_g': gain(ks[9], (N_EVEN, B_WIDTH)),
        'gm_ln_b': nrm(ks[10], (N_EVEN, B_WIDTH), 0.02),
        'gm_ws': w(ks[11], (N_EVEN, B_GROUPS, CHUNK, CHUNK), CHUNK),
        'gm_bs': 1.0 + nrm(ks[12], (N_EVEN, B_GROUPS, CHUNK), 0.02),
        'w_out0': w(ks[13], (N_EVEN, EVEN_MIX, D_MODEL), EVEN_MIX),
        'w_in1': w(ks[14], (N_ODD, D_MODEL, ODD_IN), D_MODEL),
        'q_norm': gain(ks[15], (N_ODD, Q_RANK)),
        'w_qb': w(ks[16], (N_ODD, Q_RANK, C_HEADS * (C_NOPE + C_ROPE)), Q_RANK),
        'kv_norm': gain(ks[17], (N_ODD, KV_RANK)),
        'w_kvb': w(ks[18], (N_ODD, KV_RANK, C_HEADS * (C_NOPE + C_V)), KV_RANK),
        'w_out1': w(ks[19], (N_ODD, C_WIDTH, D_MODEL), C_WIDTH),
        'final_g': gain(ks[20], (D_MODEL,)),
    }


def reference(x, c, ctx, c_ctx, norm_g, w_ada, b_ada, w_in0, sink0, gm_ln_g, gm_ln_b, gm_ws, gm_bs,
              w_out0, w_in1, q_norm, w_qb, kv_norm, w_kvb, w_out1, final_g):
    S = x.shape[1]
    row, col = grid_positions(S)
    cond_l = jax.nn.silu(c)[:, None, :]
    cond_c = jax.nn.silu(c_ctx)[None, None, :]
    xc = ctx
    for layer in range(DEPTH):
        need_ctx = layer < DEPTH - 1
        shift_l, scale_l, gate_l = jnp.split(cond_l @ w_ada[layer] + b_ada[layer], 3, axis=-1)
        shift_c, scale_c, gate_c = jnp.split(cond_c @ w_ada[layer] + b_ada[layer], 3, axis=-1)
        hl = rms_norm(x, norm_g[layer]) * (1.0 + scale_l) + shift_l
        hc = rms_norm(xc, norm_g[layer]) * (1.0 + scale_c) + shift_c
        i = layer // 2
        if layer % 2 == 0:
            yl, yc = even_layer(hl, hc, w_in0[i], sink0[i], gm_ln_g[i], gm_ln_b[i], gm_ws[i], gm_bs[i],
                                w_out0[i], row, col, need_ctx)
        else:
            yl, yc = odd_layer(hl, hc, w_in1[i], q_norm[i], w_qb[i], kv_norm[i], w_kvb[i], w_out1[i],
                               row, col, need_ctx)
        x = x + gate_l * yl
        if need_ctx:
            xc = xc + gate_c * yc
    return rms_norm(x, final_g)
```

```cpp
#ifndef HOST_TEST
#include <hip/hip_runtime.h>
#include <hip/hip_cooperative_groups.h>
#include <cstdio>
#define HD __device__ __forceinline__
#else
#include <cstdio>
#include <cstdlib>
#include <cstring>
#include <cmath>
#include <vector>
#define HD static inline
#endif
#include <cstdint>

#ifndef CFG_B
#define CFG_B 8
#endif
#ifndef CFG_S
#define CFG_S 2048
#endif
#ifndef CFG_C
#define CFG_C 256
#endif
constexpr int NB = CFG_B, SEQ = CFG_S, CTX = CFG_C, DM = 1024, GRIDW = 64;
constexpr int LROWS = NB * SEQ, CROWS = NB * CTX, ROWS = LROWS + CROWS;
constexpr int N_IN0 = 2816, N_IN1 = 1536;
constexpr int C_Q = 0, C_K = 512, C_V = 640, C_U = 768, C_VV = 1280, C_G = 1792;
constexpr float LOG2E = 1.4426950408889634f;
constexpr float QSCALE0 = 0.125f * LOG2E;
constexpr float QSCALE1 = 0.10206207261596577f * LOG2E;
constexpr float NORM_EPS = 1e-6f;

typedef unsigned short bf16_t;

constexpr size_t al(size_t x) { return (x + 4095) & ~(size_t)4095; }
constexpr size_t WS_CTL = 0;
constexpr size_t WS_WIN0 = 1u << 20;
constexpr size_t WS_WOUT0 = WS_WIN0 + al((size_t)N_IN0 * DM * 2);
constexpr size_t WS_WIN1 = WS_WOUT0 + al((size_t)DM * DM * 2);
constexpr size_t WS_WQB = WS_WIN1 + al((size_t)N_IN1 * DM * 2);
constexpr size_t WS_WKVB = WS_WQB + al((size_t)1536 * 256 * 2);
constexpr size_t WS_WOUT1 = WS_WKVB + al((size_t)2048 * 128 * 2);
constexpr size_t WS_WS = WS_WOUT1 + al((size_t)DM * DM * 2);
constexpr size_t WS_MOD = WS_WS + al((size_t)8 * 128 * 128 * 2);
constexpr size_t WS_ROPE0 = WS_MOD + al((size_t)2 * 9 * 3072 * 4);
constexpr size_t WS_ROPE1 = WS_ROPE0 + al((size_t)SEQ * 32 * 2 * 4);
constexpr size_t WS_VVP = WS_ROPE1 + al((size_t)SEQ * 16 * 2 * 4);
constexpr size_t WS_QSP = WS_VVP + al((size_t)ROWS * 16 * 4);
constexpr size_t WS_KVSP = WS_QSP + al((size_t)LROWS * 4 * 4);
constexpr size_t WS_KPE = WS_KVSP + al((size_t)ROWS * 4 * 4);
constexpr size_t WS_KVA = WS_KPE + al((size_t)ROWS * 32 * 2);
constexpr size_t WS_X1C = WS_KVA + al((size_t)ROWS * 128 * 2);
constexpr size_t WS_H = WS_X1C + al((size_t)CROWS * DM * 4);
constexpr size_t WS_K1N = WS_H;
constexpr size_t WS_P0 = WS_H + al((size_t)ROWS * DM * 2);
constexpr size_t WS_Q1 = WS_P0;
constexpr size_t WS_G1 = WS_Q1 + al((size_t)LROWS * 1536 * 2);
constexpr size_t WS_QA = WS_G1 + al((size_t)LROWS * DM * 2);
constexpr size_t WS_MIX = WS_P0 + al((size_t)ROWS * N_IN0 * 2);
constexpr size_t WS_V1 = WS_MIX + al((size_t)ROWS * DM * 2);
constexpr size_t WS_END = WS_V1 + al((size_t)ROWS * DM * 2);
static_assert(WS_QA + (size_t)LROWS * 256 * 2 <= WS_MIX, "layer-1 overlay fits in P0");
static_assert(WS_END <= (size_t)256 << 20, "workspace fits in 256 MiB");

struct Params {
    const float *x, *c, *ctx, *c_ctx, *norm_g, *w_ada, *b_ada, *w_in0, *sink0, *gm_ln_g, *gm_ln_b, *gm_ws, *gm_bs, *w_out0,
        *w_in1, *q_norm, *w_qb, *kv_norm, *w_kvb, *w_out1, *final_g;
    float* out;
    unsigned char* ws;
};

HD float bf2f(bf16_t v) { unsigned u = (unsigned)v << 16; float f; memcpy(&f, &u, 4); return f; }
HD bf16_t f2bf(float f) { unsigned u; memcpy(&u, &f, 4); return (bf16_t)((u + 0x7fffu + ((u >> 16) & 1u)) >> 16); }
HD float silu_f(float v) { return v / (1.0f + expf(-v)); }
HD float gelu_f(float v) { return 0.5f * v * (1.0f + erff(v * 0.70710678118654752f)); }
HD int pe_orig(int p) { return p < 8 ? p : (p < 16 ? p + 8 : (p < 24 ? p - 8 : p)); }

#define WSP(T, off) ((T*)(p.ws + (off)))

constexpr long W_ITEMS0 = (long)N_IN0 * DM, W_ITEMS1 = (long)DM * DM, W_ITEMS2 = (long)N_IN1 * DM, W_ITEMS3 = 1536L * 256, W_ITEMS4 = 2048L * 128,
               W_ITEMS5 = (long)DM * DM, W_ITEMS6 = 8L * 128 * 128;
constexpr long W_ITEMS = W_ITEMS0 + W_ITEMS1 + W_ITEMS2 + W_ITEMS3 + W_ITEMS4 + W_ITEMS5 + W_ITEMS6;
HD void nk_weights(const Params& p, long it) {
    if (it < W_ITEMS0) { int n = (int)(it / DM), k = (int)(it % DM); WSP(bf16_t, WS_WIN0)[it] = f2bf(p.w_in0[(size_t)k * N_IN0 + n]); return; } it -= W_ITEMS0;
    if (it < W_ITEMS1) { int n = (int)(it / DM), k = (int)(it % DM); WSP(bf16_t, WS_WOUT0)[it] = f2bf(p.w_out0[(size_t)k * DM + n]); return; } it -= W_ITEMS1;
    if (it < W_ITEMS2) { int n = (int)(it / DM), k = (int)(it % DM); float v = 0.f;
        if (n < 416) v = p.w_in1[(size_t)k * 1440 + (n < 384 ? n : 384 + pe_orig(n - 384))]; else if (n >= 512) v = p.w_in1[(size_t)k * 1440 + n - 96];
        WSP(bf16_t, WS_WIN1)[it] = f2bf(v); return; } it -= W_ITEMS2;
    if (it < W_ITEMS3) { int n = (int)(it / 256), k = (int)(it % 256); int h = n / 96, w = n % 96; int oc = h * 96 + (w < 64 ? w : 64 + pe_orig(w - 64));
        WSP(bf16_t, WS_WQB)[it] = f2bf(p.w_qb[(size_t)k * 1536 + oc] * p.q_norm[k]); return; } it -= W_ITEMS3;
    if (it < W_ITEMS4) { int n = (int)(it / 128), k = (int)(it % 128); int nn = n & 1023, h = nn >> 6, d = nn & 63; int oc = h * 128 + d + (n >= 1024 ? 64 : 0);
        WSP(bf16_t, WS_WKVB)[it] = f2bf(p.w_kvb[(size_t)k * 2048 + oc] * p.kv_norm[k]); return; } it -= W_ITEMS4;
    if (it < W_ITEMS5) { int n = (int)(it / DM), k = (int)(it % DM); WSP(bf16_t, WS_WOUT1)[it] = f2bf(p.w_out1[(size_t)k * DM + n]); return; } it -= W_ITEMS5;
    WSP(bf16_t, WS_WS)[it] = f2bf(p.gm_ws[it]);
}
constexpr long ROPE_ITEMS = (long)SEQ * 48;
HD void nk_rope(const Params& p, long it) {
    int s = (int)(it / 48), t = (int)(it % 48); float pr = (float)(s / GRIDW), pc = (float)(s % GRIDW);
    if (t < 32) { int j = t & 15; float inv = exp2f(-(float)j * (13.287712379549449f / 16.0f)); float a = (t < 16 ? pr : pc) * inv;
        float* o = WSP(float, WS_ROPE0) + ((size_t)s * 32 + t) * 2; o[0] = cosf(a); o[1] = sinf(a); }
    else { int u = t - 32, j = u & 7; float inv = exp2f(-(float)j * (13.287712379549449f / 8.0f)); float a = (u < 8 ? pr : pc) * inv;
        float* o = WSP(float, WS_ROPE1) + ((size_t)s * 16 + u) * 2; o[0] = cosf(a); o[1] = sinf(a); }
}
constexpr long ADA_ITEMS = 2L * 3072;
HD void nk_adaln(const Params& p, long it) {
    int l = (int)(it / 3072), n = (int)(it % 3072); float acc[9];
#pragma unroll
    for (int r = 0; r < 9; ++r) acc[r] = 0.f;
    const float* w = p.w_ada + (size_t)l * DM * 3072 + n;
    for (int k = 0; k < DM; ++k) { float wv = w[(size_t)k * 3072];
#pragma unroll
        for (int r = 0; r < 9; ++r) { float cv = (r < 8) ? (r < NB ? p.c[r * DM + k] : 0.f) : p.c_ctx[k]; acc[r] += silu_f(cv) * wv; } }
    float bb = p.b_ada[l * 3072 + n];
#pragma unroll
    for (int r = 0; r < 9; ++r) WSP(float, WS_MOD)[((size_t)l * 9 + r) * 3072 + n] = acc[r] + bb;
}
HD void nk_modnorm(const Params& p, long r, int layer) {
    const float* src; int mr;
    if (r < LROWS) { src = (layer == 0 ? p.x : p.out) + (size_t)r * DM; mr = (int)(r / SEQ); }
    else { src = (layer == 0 ? p.ctx : WSP(float, WS_X1C)) + (size_t)(r - LROWS) * DM; mr = 8; }
    float ss = 0.f; for (int k = 0; k < DM; ++k) ss += src[k] * src[k];
    float rstd = 1.0f / sqrtf(ss / DM + NORM_EPS);
    const float* md = WSP(float, WS_MOD) + ((size_t)layer * 9 + mr) * 3072; const float* g = p.norm_g + layer * DM;
    bf16_t* o = WSP(bf16_t, WS_H) + (size_t)r * DM;
    for (int k = 0; k < DM; ++k) o[k] = f2bf(src[k] * rstd * g[k] * (1.0f + md[1024 + k]) + md[k]);
}
HD float nk_dot(const bf16_t* a, const bf16_t* b, int K) { float s = 0.f; for (int k = 0; k < K; ++k) s += bf2f(a[k]) * bf2f(b[k]); return s; }
constexpr long IN0_ITEMS = (long)ROWS * N_IN0;
HD void nk_in0(const Params& p, long it) {
    long r = it / N_IN0; int c = (int)(it % N_IN0);
    const bf16_t* a = WSP(bf16_t, WS_H) + (size_t)r * DM; const bf16_t* W = WSP(bf16_t, WS_WIN0);
    float v = nk_dot(a, W + (size_t)c * DM, DM), o;
    if (c < C_V) {
        if (r < LROWS) { int d = c & 63, t = d & 15, second = (d >> 4) & 1, ax = d >> 5; int pc = second ? c - 16 : c + 16;
            float v2 = nk_dot(a, W + (size_t)pc * DM, DM); int s = (int)(r % SEQ); const float* cs = WSP(float, WS_ROPE0) + ((size_t)s * 32 + ax * 16 + t) * 2;
            o = second ? (v2 * cs[1] + v * cs[0]) : (v * cs[0] - v2 * cs[1]); }
        else o = v;
        if (c < C_K) o *= QSCALE0;
    } else if (c < C_U) o = v;
    else if (c < C_G) o = gelu_f(v);
    else o = silu_f(v);
    WSP(bf16_t, WS_P0)[it] = f2bf(o);
}
constexpr long VVP_ITEMS = (long)ROWS * 8;
HD void nk_vvp(const Params& p, long it) {
    long r = it / 8; int j = (int)(it % 8); const bf16_t* v = WSP(bf16_t, WS_P0) + (size_t)r * N_IN0 + C_VV + 64 * j; float s = 0.f, q = 0.f;
    for (int i = 0; i < 64; ++i) { float f = bf2f(v[i]); s += f; q += f * f; }
    float* o = WSP(float, WS_VVP) + it * 2; o[0] = s; o[1] = q;
}
constexpr long ATT0_ITEMS = (long)ROWS * 8;
HD void nk_attn0(const Params& p, long it) {
    int h = (int)(it / ROWS); long r = it % ROWS; int hk = h >> 2;
    const bf16_t* P0 = WSP(bf16_t, WS_P0); const bf16_t* qp = P0 + (size_t)r * N_IN0 + C_Q + 64 * h;
    float q[64], o[64];
#pragma unroll
    for (int d = 0; d < 64; ++d) { q[d] = bf2f(qp[d]); o[d] = 0.f; }
    float m = -1e30f, l = 0.f;
    int b, j0 = 0, j1 = 0; long cbase;
    if (r < LROWS) { b = (int)(r / SEQ); int s = (int)(r % SEQ); j0 = s - 128 < 0 ? 0 : s - 128; j1 = s + 128 > SEQ - 1 ? SEQ - 1 : s + 128; }
    else { b = (int)((r - LROWS) / CTX); j0 = 1; j1 = 0; }
    cbase = LROWS + (long)b * CTX;
    const int nloc = j1 - j0 + 1 > 0 ? j1 - j0 + 1 : 0;
    for (int t = 0; t < nloc + CTX; ++t) {
        long kr = t < nloc ? (long)b * SEQ + j0 + t : cbase + (t - nloc);
        const bf16_t* kp = P0 + (size_t)kr * N_IN0 + C_K + 64 * hk; const bf16_t* vp = P0 + (size_t)kr * N_IN0 + C_V + 64 * hk;
        float s = 0.f;
#pragma unroll
        for (int d = 0; d < 64; ++d) s += q[d] * bf2f(kp[d]);
        float mn = s > m ? s : m, a = exp2f(m - mn), pp = exp2f(s - mn); l = l * a + pp; m = mn;
#pragma unroll
        for (int d = 0; d < 64; ++d) o[d] = o[d] * a + pp * bf2f(vp[d]);
    }
    { float s = p.sink0[h] * LOG2E; float mn = s > m ? s : m, a = exp2f(m - mn), pp = exp2f(s - mn); l = l * a + pp;
#pragma unroll
      for (int d = 0; d < 64; ++d) o[d] *= a; }
    const bf16_t* gp = P0 + (size_t)r * N_IN0 + C_G + 64 * h; bf16_t* op = WSP(bf16_t, WS_MIX) + (size_t)r * DM + 64 * h; float rl = 1.0f / l;
#pragma unroll
    for (int d = 0; d < 64; ++d) op[d] = f2bf(o[d] * rl * bf2f(gp[d]));
}
constexpr long GMLP_ITEMS = (long)ROWS * 512;
HD void nk_gmlp(const Params& p, long it) {
    long r = it / 512; int c = (int)(it % 512), g = c >> 6, pp = (int)(r & 127); long r0 = r - pp;
    const bf16_t* P0 = WSP(bf16_t, WS_P0); const bf16_t* W = WSP(bf16_t, WS_WS) + ((size_t)g * 128 + pp) * 128; const float* vvp = WSP(float, WS_VVP);
    float lg = p.gm_ln_g[c], lb = p.gm_ln_b[c], s = 0.f;
    for (int q = 0; q < 128; ++q) { const float* pt = vvp + (size_t)(r0 + q) * 16; float sm = 0.f, sq = 0.f;
        for (int j = 0; j < 8; ++j) { sm += pt[2 * j]; sq += pt[2 * j + 1]; }
        float mean = sm * (1.0f / 512), var = sq * (1.0f / 512) - mean * mean, rstd = 1.0f / sqrtf(var + NORM_EPS);
        float vn = bf2f(f2bf((bf2f(P0[(size_t)(r0 + q) * N_IN0 + C_VV + c]) - mean) * rstd * lg + lb));
        s += bf2f(W[q]) * vn; }
    s += p.gm_bs[g * 128 + pp];
    float u = bf2f(P0[(size_t)r * N_IN0 + C_U + c]), gt = bf2f(P0[(size_t)r * N_IN0 + C_G + 512 + c]);
    WSP(bf16_t, WS_MIX)[(size_t)r * DM + 512 + c] = f2bf(u * s * gt);
}
constexpr long OUT0_ITEMS = (long)ROWS * DM;
HD void nk_out0(const Params& p, long it) {
    long r = it / DM; int c = (int)(it % DM);
    float y = nk_dot(WSP(bf16_t, WS_MIX) + (size_t)r * DM, WSP(bf16_t, WS_WOUT0) + (size_t)c * DM, DM);
    if (r < LROWS) { int b = (int)(r / SEQ); p.out[it] = p.x[it] + WSP(float, WS_MOD)[(size_t)b * 3072 + 2048 + c] * y; }
    else { size_t ci = (size_t)(r - LROWS) * DM + c; WSP(float, WS_X1C)[ci] = p.ctx[ci] + WSP(float, WS_MOD)[(size_t)8 * 3072 + 2048 + c] * y; }
}
constexpr long IN1_ITEMS = (long)ROWS * N_IN1;
HD void nk_in1(const Params& p, long it) {
    long r = it / N_IN1; int c = (int)(it % N_IN1);
    if (c >= 416 && c < 512) return;
    if (r >= LROWS && (c < 256 || c >= 416)) return;
    const bf16_t* a = WSP(bf16_t, WS_H) + (size_t)r * DM; const bf16_t* W = WSP(bf16_t, WS_WIN1);
    float v = nk_dot(a, W + (size_t)c * DM, DM);
    if (c < 256) WSP(bf16_t, WS_QA)[(size_t)r * 256 + c] = f2bf(v);
    else if (c < 384) WSP(bf16_t, WS_KVA)[(size_t)r * 128 + c - 256] = f2bf(v);
    else if (c < 416) { int pp = c - 384; float o = v;
        if (r < LROWS) { int second = pp >> 4, t = pp & 15; int pc = second ? c - 16 : c + 16; float v2 = nk_dot(a, W + (size_t)pc * DM, DM);
            int s = (int)(r % SEQ); const float* cs = WSP(float, WS_ROPE1) + ((size_t)s * 16 + t) * 2;
            o = second ? (v2 * cs[1] + v * cs[0]) : (v * cs[0] - v2 * cs[1]); }
        WSP(bf16_t, WS_KPE)[(size_t)r * 32 + pp] = f2bf(o); }
    else WSP(bf16_t, WS_G1)[(size_t)r * DM + c - 512] = f2bf(silu_f(v));
}
constexpr long SSP_ITEMS = (long)ROWS * 8;
HD void nk_ssp(const Params& p, long it) {
    long r = it / 8; int j = (int)(it % 8);
    if (j < 4) { if (r >= LROWS) return; const bf16_t* v = WSP(bf16_t, WS_QA) + (size_t)r * 256 + 64 * j; float q = 0.f; for (int i = 0; i < 64; ++i) { float f = bf2f(v[i]); q += f * f; }
        WSP(float, WS_QSP)[r * 4 + j] = q; }
    else { j -= 4; const bf16_t* v = WSP(bf16_t, WS_KVA) + (size_t)r * 128 + 32 * j; float q = 0.f; for (int i = 0; i < 32; ++i) { float f = bf2f(v[i]); q += f * f; }
        WSP(float, WS_KVSP)[r * 4 + j] = q; }
}
constexpr long QB_ITEMS = (long)LROWS * 1536;
HD void nk_qb(const Params& p, long it) {
    long r = it / 1536; int c = (int)(it % 1536); int w = c % 96;
    const bf16_t* a = WSP(bf16_t, WS_QA) + (size_t)r * 256; const bf16_t* W = WSP(bf16_t, WS_WQB);
    const float* sp = WSP(float, WS_QSP) + r * 4; float rstd = 1.0f / sqrtf((sp[0] + sp[1] + sp[2] + sp[3]) * (1.0f / 256) + NORM_EPS);
    float v = nk_dot(a, W + (size_t)c * 256, 256) * rstd, o = v;
    if (w >= 64) { int pp = w - 64, second = pp >> 4, t = pp & 15; int pc = second ? c - 16 : c + 16; float v2 = nk_dot(a, W + (size_t)pc * 256, 256) * rstd;
        int s = (int)(r % SEQ); const float* cs = WSP(float, WS_ROPE1) + ((size_t)s * 16 + t) * 2;
        o = second ? (v2 * cs[1] + v * cs[0]) : (v * cs[0] - v2 * cs[1]); }
    WSP(bf16_t, WS_Q1)[it] = f2bf(o * QSCALE1);
}
constexpr long KVB_ITEMS = (long)ROWS * 2048;
HD void nk_kvb(const Params& p, long it) {
    long r = it / 2048; int c = (int)(it % 2048);
    const float* sp = WSP(float, WS_KVSP) + r * 4; float rstd = 1.0f / sqrtf((sp[0] + sp[1] + sp[2] + sp[3]) * (1.0f / 128) + NORM_EPS);
    float v = nk_dot(WSP(bf16_t, WS_KVA) + (size_t)r * 128, WSP(bf16_t, WS_WKVB) + (size_t)c * 128, 128) * rstd;
    if (c < 1024) WSP(bf16_t, WS_K1N)[(size_t)r * DM + c] = f2bf(v); else WSP(bf16_t, WS_V1)[(size_t)r * DM + c - 1024] = f2bf(v);
}
constexpr long ATT1_ITEMS = (long)LROWS * 16;
HD void nk_attn1(const Params& p, long it) {
    int h = (int)(it / LROWS); long r = it % LROWS; int b = (int)(r / SEQ);
    const bf16_t* qp = WSP(bf16_t, WS_Q1) + (size_t)r * 1536 + 96 * h;
    float q[96], o[64];
#pragma unroll
    for (int d = 0; d < 96; ++d) q[d] = bf2f(qp[d]);
#pragma unroll
    for (int d = 0; d < 64; ++d) o[d] = 0.f;
    float m = -1e30f, l = 0.f;
    for (int t = 0; t < SEQ + CTX; ++t) {
        long kr = t < SEQ ? (long)b * SEQ + t : LROWS + (long)b * CTX + (t - SEQ);
        const bf16_t* kn = WSP(bf16_t, WS_K1N) + (size_t)kr * DM + 64 * h; const bf16_t* kp = WSP(bf16_t, WS_KPE) + (size_t)kr * 32; const bf16_t* vp = WSP(bf16_t, WS_V1) + (size_t)kr * DM + 64 * h;
        float s = 0.f;
#pragma unroll
        for (int d = 0; d < 64; ++d) s += q[d] * bf2f(kn[d]);
#pragma unroll
        for (int d = 0; d < 32; ++d) s += q[64 + d] * bf2f(kp[d]);
        float mn = s > m ? s : m, a = exp2f(m - mn), pp = exp2f(s - mn); l = l * a + pp; m = mn;
#pragma unroll
        for (int d = 0; d < 64; ++d) o[d] = o[d] * a + pp * bf2f(vp[d]);
    }
    const bf16_t* gp = WSP(bf16_t, WS_G1) + (size_t)r * DM + 64 * h; bf16_t* op = WSP(bf16_t, WS_MIX) + (size_t)r * DM + 64 * h; float rl = 1.0f / l;
#pragma unroll
    for (int d = 0; d < 64; ++d) op[d] = f2bf(o[d] * rl * bf2f(gp[d]));
}
constexpr long OUT1_ITEMS = (long)LROWS * DM;
HD void nk_out1(const Params& p, long it) {
    long r = it / DM; int c = (int)(it % DM); int b = (int)(r / SEQ);
    float y = nk_dot(WSP(bf16_t, WS_MIX) + (size_t)r * DM, WSP(bf16_t, WS_WOUT1) + (size_t)c * DM, DM);
    p.out[it] = p.out[it] + WSP(float, WS_MOD)[((size_t)9 + b) * 3072 + 2048 + c] * y;
}
HD void nk_final(const Params& p, long r) {
    float* o = p.out + (size_t)r * DM; float ss = 0.f; for (int k = 0; k < DM; ++k) ss += o[k] * o[k];
    float rstd = 1.0f / sqrtf(ss / DM + NORM_EPS);
    for (int k = 0; k < DM; ++k) o[k] = o[k] * rstd * p.final_g[k];
}

constexpr int N_STAGES = 16;
#ifndef HOST_TEST
__host__ __device__ inline
#else
static inline
#endif
long stage_items(int s) {
    switch (s) { case 0: return W_ITEMS; case 1: return ROPE_ITEMS; case 2: return ADA_ITEMS; case 3: return ROWS; case 4: return IN0_ITEMS; case 5: return VVP_ITEMS;
        case 6: return ATT0_ITEMS; case 7: return GMLP_ITEMS; case 8: return OUT0_ITEMS; case 9: return ROWS; case 10: return IN1_ITEMS; case 11: return SSP_ITEMS;
        case 12: return QB_ITEMS; case 13: return KVB_ITEMS; case 14: return ATT1_ITEMS; case 15: return OUT1_ITEMS; default: return LROWS; }
}
HD void stage_item(const Params& p, int s, long it) {
    switch (s) { case 0: nk_weights(p, it); break; case 1: nk_rope(p, it); break; case 2: nk_adaln(p, it); break; case 3: nk_modnorm(p, it, 0); break; case 4: nk_in0(p, it); break;
        case 5: nk_vvp(p, it); break; case 6: nk_attn0(p, it); break; case 7: nk_gmlp(p, it); break; case 8: nk_out0(p, it); break; case 9: nk_modnorm(p, it, 1); break;
        case 10: nk_in1(p, it); break; case 11: nk_ssp(p, it); break; case 12: nk_qb(p, it); break; case 13: nk_kvb(p, it); break; case 14: nk_attn1(p, it); break;
        case 15: nk_out1(p, it); break; default: nk_final(p, it); break; }
}
HD bool stage_sync_after(int s) { return !(s == 0 || s == 1 || s == 6 || s == 12); }

#ifndef HOST_TEST
namespace cg = cooperative_groups;
constexpr int NTHREADS = 512;
template <int S> __global__ void __launch_bounds__(NTHREADS) k_stage(Params p) {
    const long n = stage_items(S);
    for (long it = (long)blockIdx.x * NTHREADS + threadIdx.x; it < n; it += (long)gridDim.x * NTHREADS) stage_item(p, S, it);
}
template <int S> static void launch_stage(const Params& p, hipStream_t st) {
    long n = stage_items(S); long nb = (n + NTHREADS - 1) / NTHREADS; if (nb > 256L * 64) nb = 256L * 64;
    hipLaunchKernelGGL(k_stage<S>, dim3((unsigned)nb), dim3(NTHREADS), 0, st, p);
}
template <int S> struct LaunchAll { static void run(const Params& p, hipStream_t st) { LaunchAll<S - 1>::run(p, st); launch_stage<S>(p, st); } };
template <> struct LaunchAll<-1> { static void run(const Params&, hipStream_t) {} };

extern "C" void kernel_launch(void* const* d_in, const int* in_sizes, int n_in, void* d_out, int out_size, void* d_ws, size_t ws_size, hipStream_t stream) {
    if (n_in != 21 || ws_size < WS_END || out_size != LROWS * DM) { fprintf(stderr, "kernel_launch: unexpected sizes n_in %d out %d ws %zu (need %zu)\n", n_in, out_size, ws_size, (size_t)WS_END); return; }
    Params p{};
    const float** f = (const float**)&p;
    for (int i = 0; i < 21; ++i) f[i] = (const float*)d_in[i];
    p.out = (float*)d_out; p.ws = (unsigned char*)d_ws;
    LaunchAll<N_STAGES>::run(p, stream);
}
#else
static std::vector<float> readf(const char* path, size_t n) { std::vector<float> v(n); FILE* f = fopen(path, "rb"); if (!f) { printf("cannot open %s\n", path); exit(1); } size_t g = fread(v.data(), 4, n, f); fclose(f); if (g != n) { printf("short read %s %zu/%zu\n", path, g, n); exit(1); } return v; }
static void cmp(const char* name, const float* a, const float* b, size_t n) { double e = 0, s = 0, mx = 0; for (size_t i = 0; i < n; ++i) { double d = (double)a[i] - b[i]; e += d * d; s += (double)b[i] * b[i]; if (fabs(d) > mx) mx = fabs(d); }
    printf("%-8s rvr %.3e  rel %.3e  absmax %.3e  (ref rms %.4f)\n", name, e / s, sqrt(e / s), mx, sqrt(s / n)); }
int main(int argc, char** argv) {
    const char* dir = argc > 1 ? argv[1] : "data"; char path[512];
    const size_t sizes[21] = {(size_t)LROWS * DM, (size_t)NB * DM, (size_t)CROWS * DM, DM, 2 * DM, 2u * DM * 3072, 2 * 3072, (size_t)DM * N_IN0, 8, 512, 512, 8 * 128 * 128, 8 * 128, (size_t)DM * DM,
                              (size_t)DM * 1440, 256, 256 * 1536, 128, 128 * 2048, (size_t)DM * DM, DM};
    size_t tot = 0; for (int i = 0; i < 21; ++i) tot += sizes[i];
    snprintf(path, sizeof path, "%s/inputs.bin", dir); std::vector<float> in = readf(path, tot);
    Params p{}; const float** f = (const float**)&p; size_t off = 0; for (int i = 0; i < 21; ++i) { f[i] = in.data() + off; off += sizes[i]; }
    std::vector<float> out((size_t)LROWS * DM, NAN); std::vector<unsigned char> ws(WS_END, 0xAA); p.out = out.data(); p.ws = ws.data();
    auto dump_bf = [&](const char* nm, size_t wsoff, size_t rows, size_t pitch, size_t c0, size_t ncol, float scale) {
        snprintf(path, sizeof path, "%s/dbg_%s.bin", dir, nm); std::vector<float> ref = readf(path, rows * ncol); std::vector<float> mine(rows * ncol);
        const bf16_t* b = (const bf16_t*)(ws.data() + wsoff); for (size_t r = 0; r < rows; ++r) for (size_t c = 0; c < ncol; ++c) mine[r * ncol + c] = bf2f(b[r * pitch + c0 + c]) * scale; cmp(nm, mine.data(), ref.data(), rows * ncol); };
    for (int s = 0; s <= N_STAGES; ++s) {
        long n = stage_items(s);
#pragma omp parallel for schedule(dynamic, 256)
        for (long it = 0; it < n; ++it) stage_item(p, s, it);
        if (s == 3) {
            snprintf(path, sizeof path, "%s/dbg_h0.bin", dir); std::vector<float> ref = readf(path, (size_t)ROWS * DM); std::vector<float> mine((size_t)ROWS * DM); const bf16_t* H = (const bf16_t*)(ws.data() + WS_H);
            for (int b = 0; b < NB; ++b) for (int j = 0; j < SEQ + CTX; ++j) { size_t r = j < SEQ ? (size_t)b * SEQ + j : LROWS + (size_t)b * CTX + j - SEQ; for (int c = 0; c < DM; ++c) mine[((size_t)b * (SEQ + CTX) + j) * DM + c] = bf2f(H[r * DM + c]); }
            cmp("h0", mine.data(), ref.data(), mine.size()); }
        if (s == 4) { dump_bf("q0", WS_P0, LROWS, N_IN0, C_Q, 512, 1.0f / QSCALE0); dump_bf("k0", WS_P0, LROWS, N_IN0, C_K, 128, 1.0f); }
        if (s == 7) { snprintf(path, sizeof path, "%s/dbg_mix0.bin", dir); std::vector<float> ref = readf(path, (size_t)ROWS * DM); std::vector<float> mine((size_t)ROWS * DM); const bf16_t* H = (const bf16_t*)(ws.data() + WS_MIX);
            for (int b = 0; b < NB; ++b) for (int j = 0; j < SEQ + CTX; ++j) { size_t r = j < SEQ ? (size_t)b * SEQ + j : LROWS + (size_t)b * CTX + j - SEQ; for (int c = 0; c < DM; ++c) mine[((size_t)b * (SEQ + CTX) + j) * DM + c] = bf2f(H[r * DM + c]); }
            cmp("mix0", mine.data(), ref.data(), mine.size()); }
        if (s == 8) { snprintf(path, sizeof path, "%s/dbg_x1.bin", dir); std::vector<float> ref = readf(path, (size_t)LROWS * DM); cmp("x1", out.data(), ref.data(), ref.size()); }
        if (s == 9) { snprintf(path, sizeof path, "%s/dbg_h1.bin", dir); std::vector<float> ref = readf(path, (size_t)ROWS * DM); std::vector<float> mine((size_t)ROWS * DM); const bf16_t* H = (const bf16_t*)(ws.data() + WS_H);
            for (int b = 0; b < NB; ++b) for (int j = 0; j < SEQ + CTX; ++j) { size_t r = j < SEQ ? (size_t)b * SEQ + j : LROWS + (size_t)b * CTX + j - SEQ; for (int c = 0; c < DM; ++c) mine[((size_t)b * (SEQ + CTX) + j) * DM + c] = bf2f(H[r * DM + c]); }
            cmp("h1", mine.data(), ref.data(), mine.size()); }
        if (s == 12) {
            snprintf(path, sizeof path, "%s/dbg_q1.bin", dir); std::vector<float> ref = readf(path, (size_t)LROWS * 1536); std::vector<float> mine((size_t)LROWS * 1536); const bf16_t* Q = (const bf16_t*)(ws.data() + WS_Q1);
            for (size_t r = 0; r < (size_t)LROWS; ++r) for (int c = 0; c < 1536; ++c) { int h = c / 96, w = c % 96; int oc = h * 96 + (w < 64 ? w : 64 + pe_orig(w - 64)); mine[r * 1536 + oc] = bf2f(Q[r * 1536 + c]) / QSCALE1; }
            cmp("q1", mine.data(), ref.data(), mine.size()); }
        if (s == 15) { snprintf(path, sizeof path, "%s/dbg_x2.bin", dir); std::vector<float> ref = readf(path, (size_t)LROWS * DM); cmp("x2", out.data(), ref.data(), ref.size()); }
    }
    snprintf(path, sizeof path, "%s/out.bin", dir); std::vector<float> ref = readf(path, (size_t)LROWS * DM); cmp("out", out.data(), ref.data(), ref.size());
    return 0;
}
#endif
```

```cpp
#ifndef HOST_TEST
#include <hip/hip_runtime.h>
#include <hip/hip_cooperative_groups.h>
#include <cstdio>
#define HD __device__ __forceinline__
#else
#include <cstdio>
#include <cstdlib>
#include <cstring>
#include <cmath>
#include <vector>
#define HD static inline
#endif
#include <cstdint>

#ifndef CFG_B
#define CFG_B 8
#endif
#ifndef CFG_S
#define CFG_S 2048
#endif
#ifndef CFG_C
#define CFG_C 256
#endif
constexpr int NB = CFG_B, SEQ = CFG_S, CTX = CFG_C, DM = 1024, GRIDW = 64;
constexpr int LROWS = NB * SEQ, CROWS = NB * CTX, ROWS = LROWS + CROWS;
constexpr int N_IN0 = 2816, N_IN1 = 1536;
constexpr int C_Q = 0, C_K = 512, C_V = 640, C_U = 768, C_VV = 1280, C_G = 1792;
constexpr float LOG2E = 1.4426950408889634f;
constexpr float QSCALE0 = 0.125f * LOG2E;
constexpr float QSCALE1 = 0.10206207261596577f * LOG2E;
constexpr float NORM_EPS = 1e-6f;

typedef unsigned short bf16_t;

constexpr size_t al(size_t x) { return (x + 4095) & ~(size_t)4095; }
constexpr size_t WS_CTL = 0;
constexpr size_t WS_WIN0 = 1u << 20;
constexpr size_t WS_WOUT0 = WS_WIN0 + al((size_t)N_IN0 * DM * 2);
constexpr size_t WS_WIN1 = WS_WOUT0 + al((size_t)DM * DM * 2);
constexpr size_t WS_WQB = WS_WIN1 + al((size_t)N_IN1 * DM * 2);
constexpr size_t WS_WKVB = WS_WQB + al((size_t)1536 * 256 * 2);
constexpr size_t WS_WOUT1 = WS_WKVB + al((size_t)2048 * 128 * 2);
constexpr size_t WS_WS = WS_WOUT1 + al((size_t)DM * DM * 2);
constexpr size_t WS_MOD = WS_WS + al((size_t)8 * 128 * 128 * 2);
constexpr size_t WS_ROPE0 = WS_MOD + al((size_t)2 * 9 * 3072 * 4);
constexpr size_t WS_ROPE1 = WS_ROPE0 + al((size_t)SEQ * 32 * 2 * 4);
constexpr size_t WS_VVP = WS_ROPE1 + al((size_t)SEQ * 16 * 2 * 4);
constexpr size_t WS_QSP = WS_VVP + al((size_t)ROWS * 16 * 4);
constexpr size_t WS_KVSP = WS_QSP + al((size_t)LROWS * 4 * 4);
constexpr size_t WS_KPE = WS_KVSP + al((size_t)ROWS * 4 * 4);
constexpr size_t WS_KVA = WS_KPE + al((size_t)ROWS * 32 * 2);
constexpr size_t WS_X1C = WS_KVA + al((size_t)ROWS * 128 * 2);
constexpr size_t WS_H = WS_X1C + al((size_t)CROWS * DM * 4);
constexpr size_t WS_K1N = WS_H;
constexpr size_t WS_P0 = WS_H + al((size_t)ROWS * DM * 2);
constexpr size_t WS_Q1 = WS_P0;
constexpr size_t WS_G1 = WS_Q1 + al((size_t)LROWS * 1536 * 2);
constexpr size_t WS_QA = WS_G1 + al((size_t)LROWS * DM * 2);
constexpr size_t WS_MIX = WS_P0 + al((size_t)ROWS * N_IN0 * 2);
constexpr size_t WS_V1 = WS_MIX + al((size_t)ROWS * DM * 2);
constexpr size_t WS_END = WS_V1 + al((size_t)ROWS * DM * 2);
static_assert(WS_QA + (size_t)LROWS * 256 * 2 <= WS_MIX, "layer-1 overlay fits in P0");
static_assert(WS_END <= (size_t)256 << 20, "workspace fits in 256 MiB");

struct Params {
    const float *x, *c, *ctx, *c_ctx, *norm_g, *w_ada, *b_ada, *w_in0, *sink0, *gm_ln_g, *gm_ln_b, *gm_ws, *gm_bs, *w_out0,
        *w_in1, *q_norm, *w_qb, *kv_norm, *w_kvb, *w_out1, *final_g;
    float* out;
    unsigned char* ws;
};

HD float bf2f(bf16_t v) { unsigned u = (unsigned)v << 16; float f; memcpy(&f, &u, 4); return f; }
HD bf16_t f2bf(float f) { unsigned u; memcpy(&u, &f, 4); return (bf16_t)((u + 0x7fffu + ((u >> 16) & 1u)) >> 16); }
HD float silu_f(float v) { return v / (1.0f + expf(-v)); }
HD float gelu_f(float v) { return 0.5f * v * (1.0f + erff(v * 0.70710678118654752f)); }
HD int pe_orig(int p) { return p < 8 ? p : (p < 16 ? p + 8 : (p < 24 ? p - 8 : p)); }

#define WSP(T, off) ((T*)(p.ws + (off)))

constexpr long W_ITEMS0 = (long)N_IN0 * DM, W_ITEMS1 = (long)DM * DM, W_ITEMS2 = (long)N_IN1 * DM, W_ITEMS3 = 1536L * 256, W_ITEMS4 = 2048L * 128,
               W_ITEMS5 = (long)DM * DM, W_ITEMS6 = 8L * 128 * 128;
constexpr long W_ITEMS = W_ITEMS0 + W_ITEMS1 + W_ITEMS2 + W_ITEMS3 + W_ITEMS4 + W_ITEMS5 + W_ITEMS6;
HD void nk_weights(const Params& p, long it) {
    if (it < W_ITEMS0) { int n = (int)(it / DM), k = (int)(it % DM); WSP(bf16_t, WS_WIN0)[it] = f2bf(p.w_in0[(size_t)k * N_IN0 + n]); return; } it -= W_ITEMS0;
    if (it < W_ITEMS1) { int n = (int)(it / DM), k = (int)(it % DM); WSP(bf16_t, WS_WOUT0)[it] = f2bf(p.w_out0[(size_t)k * DM + n]); return; } it -= W_ITEMS1;
    if (it < W_ITEMS2) { int n = (int)(it / DM), k = (int)(it % DM); float v = 0.f;
        if (n < 416) v = p.w_in1[(size_t)k * 1440 + (n < 384 ? n : 384 + pe_orig(n - 384))]; else if (n >= 512) v = p.w_in1[(size_t)k * 1440 + n - 96];
        WSP(bf16_t, WS_WIN1)[it] = f2bf(v); return; } it -= W_ITEMS2;
    if (it < W_ITEMS3) { int n = (int)(it / 256), k = (int)(it % 256); int h = n / 96, w = n % 96; int oc = h * 96 + (w < 64 ? w : 64 + pe_orig(w - 64));
        WSP(bf16_t, WS_WQB)[it] = f2bf(p.w_qb[(size_t)k * 1536 + oc] * p.q_norm[k]); return; } it -= W_ITEMS3;
    if (it < W_ITEMS4) { int n = (int)(it / 128), k = (int)(it % 128); int nn = n & 1023, h = nn >> 6, d = nn & 63; int oc = h * 128 + d + (n >= 1024 ? 64 : 0);
        WSP(bf16_t, WS_WKVB)[it] = f2bf(p.w_kvb[(size_t)k * 2048 + oc] * p.kv_norm[k]); return; } it -= W_ITEMS4;
    if (it < W_ITEMS5) { int n = (int)(it / DM), k = (int)(it % DM); WSP(bf16_t, WS_WOUT1)[it] = f2bf(p.w_out1[(size_t)k * DM + n]); return; } it -= W_ITEMS5;
    WSP(bf16_t, WS_WS)[it] = f2bf(p.gm_ws[it]);
}
constexpr long ROPE_ITEMS = (long)SEQ * 48;
HD void nk_rope(const Params& p, long it) {
    int s = (int)(it / 48), t = (int)(it % 48); float pr = (float)(s / GRIDW), pc = (float)(s % GRIDW);
    if (t < 32) { int j = t & 15; float inv = exp2f(-(float)j * (13.287712379549449f / 16.0f)); float a = (t < 16 ? pr : pc) * inv;
        float* o = WSP(float, WS_ROPE0) + ((size_t)s * 32 + t) * 2; o[0] = cosf(a); o[1] = sinf(a); }
    else { int u = t - 32, j = u & 7; float inv = exp2f(-(float)j * (13.287712379549449f / 8.0f)); float a = (u < 8 ? pr : pc) * inv;
        float* o = WSP(float, WS_ROPE1) + ((size_t)s * 16 + u) * 2; o[0] = cosf(a); o[1] = sinf(a); }
}
constexpr long ADA_ITEMS = 2L * 3072;
HD void nk_adaln(const Params& p, long it) {
    int l = (int)(it / 3072), n = (int)(it % 3072); float acc[9];
#pragma unroll
    for (int r = 0; r < 9; ++r) acc[r] = 0.f;
    const float* w = p.w_ada + (size_t)l * DM * 3072 + n;
    for (int k = 0; k < DM; ++k) { float wv = w[(size_t)k * 3072];
#pragma unroll
        for (int r = 0; r < 9; ++r) { float cv = (r < 8) ? (r < NB ? p.c[r * DM + k] : 0.f) : p.c_ctx[k]; acc[r] += silu_f(cv) * wv; } }
    float bb = p.b_ada[l * 3072 + n];
#pragma unroll
    for (int r = 0; r < 9; ++r) WSP(float, WS_MOD)[((size_t)l * 9 + r) * 3072 + n] = acc[r] + bb;
}
HD void nk_modnorm(const Params& p, long r, int layer) {
    const float* src; int mr;
    if (r < LROWS) { src = (layer == 0 ? p.x : p.out) + (size_t)r * DM; mr = (int)(r / SEQ); }
    else { src = (layer == 0 ? p.ctx : WSP(float, WS_X1C)) + (size_t)(r - LROWS) * DM; mr = 8; }
    float ss = 0.f; for (int k = 0; k < DM; ++k) ss += src[k] * src[k];
    float rstd = 1.0f / sqrtf(ss / DM + NORM_EPS);
    const float* md = WSP(float, WS_MOD) + ((size_t)layer * 9 + mr) * 3072; const float* g = p.norm_g + layer * DM;
    bf16_t* o = WSP(bf16_t, WS_H) + (size_t)r * DM;
    for (int k = 0; k < DM; ++k) o[k] = f2bf(src[k] * rstd * g[k] * (1.0f + md[1024 + k]) + md[k]);
}
HD float nk_dot(const bf16_t* a, const bf16_t* b, int K) { float s = 0.f; for (int k = 0; k < K; ++k) s += bf2f(a[k]) * bf2f(b[k]); return s; }
constexpr long IN0_ITEMS = (long)ROWS * N_IN0;
HD void nk_in0(const Params& p, long it) {
    long r = it / N_IN0; int c = (int)(it % N_IN0);
    const bf16_t* a = WSP(bf16_t, WS_H) + (size_t)r * DM; const bf16_t* W = WSP(bf16_t, WS_WIN0);
    float v = nk_dot(a, W + (size_t)c * DM, DM), o;
    if (c < C_V) {
        if (r < LROWS) { int d = c & 63, t = d & 15, second = (d >> 4) & 1, ax = d >> 5; int pc = second ? c - 16 : c + 16;
            float v2 = nk_dot(a, W + (size_t)pc * DM, DM); int s = (int)(r % SEQ); const float* cs = WSP(float, WS_ROPE0) + ((size_t)s * 32 + ax * 16 + t) * 2;
            o = second ? (v2 * cs[1] + v * cs[0]) : (v * cs[0] - v2 * cs[1]); }
        else o = v;
        if (c < C_K) o *= QSCALE0;
    } else if (c < C_U) o = v;
    else if (c < C_G) o = gelu_f(v);
    else o = silu_f(v);
    WSP(bf16_t, WS_P0)[it] = f2bf(o);
}
constexpr long VVP_ITEMS = (long)ROWS * 8;
HD void nk_vvp(const Params& p, long it) {
    long r = it / 8; int j = (int)(it % 8); const bf16_t* v = WSP(bf16_t, WS_P0) + (size_t)r * N_IN0 + C_VV + 64 * j; float s = 0.f, q = 0.f;
    for (int i = 0; i < 64; ++i) { float f = bf2f(v[i]); s += f; q += f * f; }
    float* o = WSP(float, WS_VVP) + it * 2; o[0] = s; o[1] = q;
}
constexpr long ATT0_ITEMS = (long)ROWS * 8;
HD void nk_attn0(const Params& p, long it) {
    int h = (int)(it / ROWS); long r = it % ROWS; int hk = h >> 2;
    const bf16_t* P0 = WSP(bf16_t, WS_P0); const bf16_t* qp = P0 + (size_t)r * N_IN0 + C_Q + 64 * h;
    float q[64], o[64];
#pragma unroll
    for (int d = 0; d < 64; ++d) { q[d] = bf2f(qp[d]); o[d] = 0.f; }
    float m = -1e30f, l = 0.f;
    int b, j0 = 0, j1 = 0; long cbase;
    if (r < LROWS) { b = (int)(r / SEQ); int s = (int)(r % SEQ); j0 = s - 128 < 0 ? 0 : s - 128; j1 = s + 128 > SEQ - 1 ? SEQ - 1 : s + 128; }
    else { b = (int)((r - LROWS) / CTX); j0 = 1; j1 = 0; }
    cbase = LROWS + (long)b * CTX;
    const int nloc = j1 - j0 + 1 > 0 ? j1 - j0 + 1 : 0;
    for (int t = 0; t < nloc + CTX; ++t) {
        long kr = t < nloc ? (long)b * SEQ + j0 + t : cbase + (t - nloc);
        const bf16_t* kp = P0 + (size_t)kr * N_IN0 + C_K + 64 * hk; const bf16_t* vp = P0 + (size_t)kr * N_IN0 + C_V + 64 * hk;
        float s = 0.f;
#pragma unroll
        for (int d = 0; d < 64; ++d) s += q[d] * bf2f(kp[d]);
        float mn = s > m ? s : m, a = exp2f(m - mn), pp = exp2f(s - mn); l = l * a + pp; m = mn;
#pragma unroll
        for (int d = 0; d < 64; ++d) o[d] = o[d] * a + pp * bf2f(vp[d]);
    }
    { float s = p.sink0[h] * LOG2E; float mn = s > m ? s : m, a = exp2f(m - mn), pp = exp2f(s - mn); l = l * a + pp;
#pragma unroll
      for (int d = 0; d < 64; ++d) o[d] *= a; }
    const bf16_t* gp = P0 + (size_t)r * N_IN0 + C_G + 64 * h; bf16_t* op = WSP(bf16_t, WS_MIX) + (size_t)r * DM + 64 * h; float rl = 1.0f / l;
#pragma unroll
    for (int d = 0; d < 64; ++d) op[d] = f2bf(o[d] * rl * bf2f(gp[d]));
}
constexpr long GMLP_ITEMS = (long)ROWS * 512;
HD void nk_gmlp(const Params& p, long it) {
    long r = it / 512; int c = (int)(it % 512), g = c >> 6, pp = (int)(r & 127); long r0 = r - pp;
    const bf16_t* P0 = WSP(bf16_t, WS_P0); const bf16_t* W = WSP(bf16_t, WS_WS) + ((size_t)g * 128 + pp) * 128; const float* vvp = WSP(float, WS_VVP);
    float lg = p.gm_ln_g[c], lb = p.gm_ln_b[c], s = 0.f;
    for (int q = 0; q < 128; ++q) { const float* pt = vvp + (size_t)(r0 + q) * 16; float sm = 0.f, sq = 0.f;
        for (int j = 0; j < 8; ++j) { sm += pt[2 * j]; sq += pt[2 * j + 1]; }
        float mean = sm * (1.0f / 512), var = sq * (1.0f / 512) - mean * mean, rstd = 1.0f / sqrtf(var + NORM_EPS);
        float vn = bf2f(f2bf((bf2f(P0[(size_t)(r0 + q) * N_IN0 + C_VV + c]) - mean) * rstd * lg + lb));
        s += bf2f(W[q]) * vn; }
    s += p.gm_bs[g * 128 + pp];
    float u = bf2f(P0[(size_t)r * N_IN0 + C_U + c]), gt = bf2f(P0[(size_t)r * N_IN0 + C_G + 512 + c]);
    WSP(bf16_t, WS_MIX)[(size_t)r * DM + 512 + c] = f2bf(u * s * gt);
}
constexpr long OUT0_ITEMS = (long)ROWS * DM;
HD void nk_out0(const Params& p, long it) {
    long r = it / DM; int c = (int)(it % DM);
    float y = nk_dot(WSP(bf16_t, WS_MIX) + (size_t)r * DM, WSP(bf16_t, WS_WOUT0) + (size_t)c * DM, DM);
    if (r < LROWS) { int b = (int)(r / SEQ); p.out[it] = p.x[it] + WSP(float, WS_MOD)[(size_t)b * 3072 + 2048 + c] * y; }
    else { size_t ci = (size_t)(r - LROWS) * DM + c; WSP(float, WS_X1C)[ci] = p.ctx[ci] + WSP(float, WS_MOD)[(size_t)8 * 3072 + 2048 + c] * y; }
}
constexpr long IN1_ITEMS = (long)ROWS * N_IN1;
HD void nk_in1(const Params& p, long it) {
    long r = it / N_IN1; int c = (int)(it % N_IN1);
    if (c >= 416 && c < 512) return;
    if (r >= LROWS && (c < 256 || c >= 416)) return;
    const bf16_t* a = WSP(bf16_t, WS_H) + (size_t)r * DM; const bf16_t* W = WSP(bf16_t, WS_WIN1);
    float v = nk_dot(a, W + (size_t)c * DM, DM);
    if (c < 256) WSP(bf16_t, WS_QA)[(size_t)r * 256 + c] = f2bf(v);
    else if (c < 384) WSP(bf16_t, WS_KVA)[(size_t)r * 128 + c - 256] = f2bf(v);
    else if (c < 416) { int pp = c - 384; float o = v;
        if (r < LROWS) { int second = pp >> 4, t = pp & 15; int pc = second ? c - 16 : c + 16; float v2 = nk_dot(a, W + (size_t)pc * DM, DM);
            int s = (int)(r % SEQ); const float* cs = WSP(float, WS_ROPE1) + ((size_t)s * 16 + t) * 2;
            o = second ? (v2 * cs[1] + v * cs[0]) : (v * cs[0] - v2 * cs[1]); }
        WSP(bf16_t, WS_KPE)[(size_t)r * 32 + pp] = f2bf(o); }
    else WSP(bf16_t, WS_G1)[(size_t)r * DM + c - 512] = f2bf(silu_f(v));
}
constexpr long SSP_ITEMS = (long)ROWS * 8;
HD void nk_ssp(const Params& p, long it) {
    long r = it / 8; int j = (int)(it % 8);
    if (j < 4) { if (r >= LROWS) return; const bf16_t* v = WSP(bf16_t, WS_QA) + (size_t)r * 256 + 64 * j; float q = 0.f; for (int i = 0; i < 64; ++i) { float f = bf2f(v[i]); q += f * f; }
        WSP(float, WS_QSP)[r * 4 + j] = q; }
    else { j -= 4; const bf16_t* v = WSP(bf16_t, WS_KVA) + (size_t)r * 128 + 32 * j; float q = 0.f; for (int i = 0; i < 32; ++i) { float f = bf2f(v[i]); q += f * f; }
        WSP(float, WS_KVSP)[r * 4 + j] = q; }
}
constexpr long QB_ITEMS = (long)LROWS * 1536;
HD void nk_qb(const Params& p, long it) {
    long r = it / 1536; int c = (int)(it % 1536); int w = c % 96;
    const bf16_t* a = WSP(bf16_t, WS_QA) + (size_t)r * 256; const bf16_t* W = WSP(bf16_t, WS_WQB);
    const float* sp = WSP(float, WS_QSP) + r * 4; float rstd = 1.0f / sqrtf((sp[0] + sp[1] + sp[2] + sp[3]) * (1.0f / 256) + NORM_EPS);
    float v = nk_dot(a, W + (size_t)c * 256, 256) * rstd, o = v;
    if (w >= 64) { int pp = w - 64, second = pp >> 4, t = pp & 15; int pc = second ? c - 16 : c + 16; float v2 = nk_dot(a, W + (size_t)pc * 256, 256) * rstd;
        int s = (int)(r % SEQ); const float* cs = WSP(float, WS_ROPE1) + ((size_t)s * 16 + t) * 2;
        o = second ? (v2 * cs[1] + v * cs[0]) : (v * cs[0] - v2 * cs[1]); }
    WSP(bf16_t, WS_Q1)[it] = f2bf(o * QSCALE1);
}
constexpr long KVB_ITEMS = (long)ROWS * 2048;
HD void nk_kvb(const Params& p, long it) {
    long r = it / 2048; int c = (int)(it % 2048);
    const float* sp = WSP(float, WS_KVSP) + r * 4; float rstd = 1.0f / sqrtf((sp[0] + sp[1] + sp[2] + sp[3]) * (1.0f / 128) + NORM_EPS);
    float v = nk_dot(WSP(bf16_t, WS_KVA) + (size_t)r * 128, WSP(bf16_t, WS_WKVB) + (size_t)c * 128, 128) * rstd;
    if (c < 1024) WSP(bf16_t, WS_K1N)[(size_t)r * DM + c] = f2bf(v); else WSP(bf16_t, WS_V1)[(size_t)r * DM + c - 1024] = f2bf(v);
}
constexpr long ATT1_ITEMS = (long)LROWS * 16;
HD void nk_attn1(const Params& p, long it) {
    int h = (int)(it / LROWS); long r = it % LROWS; int b = (int)(r / SEQ);
    const bf16_t* qp = WSP(bf16_t, WS_Q1) + (size_t)r * 1536 + 96 * h;
    float q[96], o[64];
#pragma unroll
    for (int d = 0; d < 96; ++d) q[d] = bf2f(qp[d]);
#pragma unroll
    for (int d = 0; d < 64; ++d) o[d] = 0.f;
    float m = -1e30f, l = 0.f;
    for (int t = 0; t < SEQ + CTX; ++t) {
        long kr = t < SEQ ? (long)b * SEQ + t : LROWS + (long)b * CTX + (t - SEQ);
        const bf16_t* kn = WSP(bf16_t, WS_K1N) + (size_t)kr * DM + 64 * h; const bf16_t* kp = WSP(bf16_t, WS_KPE) + (size_t)kr * 32; const bf16_t* vp = WSP(bf16_t, WS_V1) + (size_t)kr * DM + 64 * h;
        float s = 0.f;
#pragma unroll
        for (int d = 0; d < 64; ++d) s += q[d] * bf2f(kn[d]);
#pragma unroll
        for (int d = 0; d < 32; ++d) s += q[64 + d] * bf2f(kp[d]);
        float mn = s > m ? s : m, a = exp2f(m - mn), pp = exp2f(s - mn); l = l * a + pp; m = mn;
#pragma unroll
        for (int d = 0; d < 64; ++d) o[d] = o[d] * a + pp * bf2f(vp[d]);
    }
    const bf16_t* gp = WSP(bf16_t, WS_G1) + (size_t)r * DM + 64 * h; bf16_t* op = WSP(bf16_t, WS_MIX) + (size_t)r * DM + 64 * h; float rl = 1.0f / l;
#pragma unroll
    for (int d = 0; d < 64; ++d) op[d] = f2bf(o[d] * rl * bf2f(gp[d]));
}
constexpr long OUT1_ITEMS = (long)LROWS * DM;
HD void nk_out1(const Params& p, long it) {
    long r = it / DM; int c = (int)(it % DM); int b = (int)(r / SEQ);
    float y = nk_dot(WSP(bf16_t, WS_MIX) + (size_t)r * DM, WSP(bf16_t, WS_WOUT1) + (size_t)c * DM, DM);
    p.out[it] = p.out[it] + WSP(float, WS_MOD)[((size_t)9 + b) * 3072 + 2048 + c] * y;
}
HD void nk_final(const Params& p, long r) {
    float* o = p.out + (size_t)r * DM; float ss = 0.f; for (int k = 0; k < DM; ++k) ss += o[k] * o[k];
    float rstd = 1.0f / sqrtf(ss / DM + NORM_EPS);
    for (int k = 0; k < DM; ++k) o[k] = o[k] * rstd * p.final_g[k];
}

constexpr int N_STAGES = 16;
#ifndef HOST_TEST
__host__ __device__ inline
#else
static inline
#endif
long stage_items(int s) {
    switch (s) { case 0: return W_ITEMS; case 1: return ROPE_ITEMS; case 2: return ADA_ITEMS; case 3: return ROWS; case 4: return IN0_ITEMS; case 5: return VVP_ITEMS;
        case 6: return ATT0_ITEMS; case 7: return GMLP_ITEMS; case 8: return OUT0_ITEMS; case 9: return ROWS; case 10: return IN1_ITEMS; case 11: return SSP_ITEMS;
        case 12: return QB_ITEMS; case 13: return KVB_ITEMS; case 14: return ATT1_ITEMS; case 15: return OUT1_ITEMS; default: return LROWS; }
}
HD void stage_item(const Params& p, int s, long it) {
    switch (s) { case 0: nk_weights(p, it); break; case 1: nk_rope(p, it); break; case 2: nk_adaln(p, it); break; case 3: nk_modnorm(p, it, 0); break; case 4: nk_in0(p, it); break;
        case 5: nk_vvp(p, it); break; case 6: nk_attn0(p, it); break; case 7: nk_gmlp(p, it); break; case 8: nk_out0(p, it); break; case 9: nk_modnorm(p, it, 1); break;
        case 10: nk_in1(p, it); break; case 11: nk_ssp(p, it); break; case 12: nk_qb(p, it); break; case 13: nk_kvb(p, it); break; case 14: nk_attn1(p, it); break;
        case 15: nk_out1(p, it); break; default: nk_final(p, it); break; }
}
HD bool stage_sync_after(int s) { return !(s == 0 || s == 1 || s == 6 || s == 12); }

#ifndef HOST_TEST
namespace cg = cooperative_groups;
constexpr int NTHREADS = 512;
template <int S> __global__ void __launch_bounds__(NTHREADS) k_stage(Params p) {
    const long n = stage_items(S);
    for (long it = (long)blockIdx.x * NTHREADS + threadIdx.x; it < n; it += (long)gridDim.x * NTHREADS) stage_item(p, S, it);
}
template <int S> static void launch_stage(const Params& p, hipStream_t st) {
    long n = stage_items(S); long nb = (n + NTHREADS - 1) / NTHREADS; if (nb > 256L * 64) nb = 256L * 64;
    hipLaunchKernelGGL(k_stage<S>, dim3((unsigned)nb), dim3(NTHREADS), 0, st, p);
}
template <int S> struct LaunchAll { static void run(const Params& p, hipStream_t st) { LaunchAll<S - 1>::run(p, st); launch_stage<S>(p, st); } };
template <> struct LaunchAll<-1> { static void run(const Params&, hipStream_t) {} };

template <int S> __device__ __forceinline__ void run_stages(const Params& p, cg::grid_group& grid) {
    if constexpr (S > 0) run_stages<S - 1>(p, grid);
    const long n = stage_items(S);
    for (long it = (long)blockIdx.x * NTHREADS + threadIdx.x; it < n; it += (long)gridDim.x * NTHREADS) stage_item(p, S, it);
    if (S < N_STAGES && stage_sync_after(S)) grid.sync();
}
__global__ void __launch_bounds__(NTHREADS) k_fwd(Params p) {
    cg::grid_group grid = cg::this_grid();
    run_stages<N_STAGES>(p, grid);
}
#ifndef ONE_LAUNCH
#define ONE_LAUNCH 1
#endif
extern "C" void kernel_launch(void* const* d_in, const int* in_sizes, int n_in, void* d_out, int out_size, void* d_ws, size_t ws_size, hipStream_t stream) {
    if (n_in != 21 || ws_size < WS_END || out_size != LROWS * DM) { fprintf(stderr, "kernel_launch: unexpected sizes n_in %d out %d ws %zu (need %zu)\n", n_in, out_size, ws_size, (size_t)WS_END); return; }
    Params p{};
    const float** f = (const float**)&p;
    for (int i = 0; i < 21; ++i) f[i] = (const float*)d_in[i];
    p.out = (float*)d_out; p.ws = (unsigned char*)d_ws;
#if ONE_LAUNCH
    static int grid_blocks = 0;
    if (!grid_blocks) {
        int dev = 0, cus = 0, per_cu = 0;
        hipGetDevice(&dev);
        hipDeviceGetAttribute(&cus, hipDeviceAttributeMultiprocessorCount, dev);
        hipOccupancyMaxActiveBlocksPerMultiprocessor(&per_cu, k_fwd, NTHREADS, 0);
        if (per_cu < 1) { fprintf(stderr, "kernel_launch: occupancy query says %d blocks/CU\n", per_cu); per_cu = 1; }
        if (per_cu > 1) per_cu = 1;
        grid_blocks = cus * per_cu;
    }
    void* args[] = {&p};
    hipError_t e = hipLaunchCooperativeKernel((void*)k_fwd, dim3(grid_blocks), dim3(NTHREADS), args, 0, stream);
    if (e != hipSuccess) fprintf(stderr, "cooperative launch failed: %s (grid %d)\n", hipGetErrorString(e), grid_blocks);
#else
    LaunchAll<N_STAGES>::run(p, stream);
#endif
}
#else
static std::vector<float> readf(const char* path, size_t n) { std::vector<float> v(n); FILE* f = fopen(path, "rb"); if (!f) { printf("cannot open %s\n", path); exit(1); } size_t g = fread(v.data(), 4, n, f); fclose(f); if (g != n) { printf("short read %s %zu/%zu\n", path, g, n); exit(1); } return v; }
static void cmp(const char* name, const float* a, const float* b, size_t n) { double e = 0, s = 0, mx = 0; for (size_t i = 0; i < n; ++i) { double d = (double)a[i] - b[i]; e += d * d; s += (double)b[i] * b[i]; if (fabs(d) > mx) mx = fabs(d); }
    printf("%-8s rvr %.3e  rel %.3e  absmax %.3e  (ref rms %.4f)\n", name, e / s, sqrt(e / s), mx, sqrt(s / n)); }
int main(int argc, char** argv) {
    const char* dir = argc > 1 ? argv[1] : "data"; char path[512];
    const size_t sizes[21] = {(size_t)LROWS * DM, (size_t)NB * DM, (size_t)CROWS * DM, DM, 2 * DM, 2u * DM * 3072, 2 * 3072, (size_t)DM * N_IN0, 8, 512, 512, 8 * 128 * 128, 8 * 128, (size_t)DM * DM,
                              (size_t)DM * 1440, 256, 256 * 1536, 128, 128 * 2048, (size_t)DM * DM, DM};
    size_t tot = 0; for (int i = 0; i < 21; ++i) tot += sizes[i];
    snprintf(path, sizeof path, "%s/inputs.bin", dir); std::vector<float> in = readf(path, tot);
    Params p{}; const float** f = (const float**)&p; size_t off = 0; for (int i = 0; i < 21; ++i) { f[i] = in.data() + off; off += sizes[i]; }
    std::vector<float> out((size_t)LROWS * DM, NAN); std::vector<unsigned char> ws(WS_END, 0xAA); p.out = out.data(); p.ws = ws.data();
    auto dump_bf = [&](const char* nm, size_t wsoff, size_t rows, size_t pitch, size_t c0, size_t ncol, float scale) {
        snprintf(path, sizeof path, "%s/dbg_%s.bin", dir, nm); std::vector<float> ref = readf(path, rows * ncol); std::vector<float> mine(rows * ncol);
        const bf16_t* b = (const bf16_t*)(ws.data() + wsoff); for (size_t r = 0; r < rows; ++r) for (size_t c = 0; c < ncol; ++c) mine[r * ncol + c] = bf2f(b[r * pitch + c0 + c]) * scale; cmp(nm, mine.data(), ref.data(), rows * ncol); };
    for (int s = 0; s <= N_STAGES; ++s) {
        long n = stage_items(s);
#pragma omp parallel for schedule(dynamic, 256)
        for (long it = 0; it < n; ++it) stage_item(p, s, it);
        if (s == 3) {
            snprintf(path, sizeof path, "%s/dbg_h0.bin", dir); std::vector<float> ref = readf(path, (size_t)ROWS * DM); std::vector<float> mine((size_t)ROWS * DM); const bf16_t* H = (const bf16_t*)(ws.data() + WS_H);
            for (int b = 0; b < NB; ++b) for (int j = 0; j < SEQ + CTX; ++j) { size_t r = j < SEQ ? (size_t)b * SEQ + j : LROWS + (size_t)b * CTX + j - SEQ; for (int c = 0; c < DM; ++c) mine[((size_t)b * (SEQ + CTX) + j) * DM + c] = bf2f(H[r * DM + c]); }
            cmp("h0", mine.data(), ref.data(), mine.size()); }
        if (s == 4) { dump_bf("q0", WS_P0, LROWS, N_IN0, C_Q, 512, 1.0f / QSCALE0); dump_bf("k0", WS_P0, LROWS, N_IN0, C_K, 128, 1.0f); }
        if (s == 7) { snprintf(path, sizeof path, "%s/dbg_mix0.bin", dir); std::vector<float> ref = readf(path, (size_t)ROWS * DM); std::vector<float> mine((size_t)ROWS * DM); const bf16_t* H = (const bf16_t*)(ws.data() + WS_MIX);
            for (int b = 0; b < NB; ++b) for (int j = 0; j < SEQ + CTX; ++j) { size_t r = j < SEQ ? (size_t)b * SEQ + j : LROWS + (size_t)b * CTX + j - SEQ; for (int c = 0; c < DM; ++c) mine[((size_t)b * (SEQ + CTX) + j) * DM + c] = bf2f(H[r * DM + c]); }
            cmp("mix0", mine.data(), ref.data(), mine.size()); }
        if (s == 8) { snprintf(path, sizeof path, "%s/dbg_x1.bin", dir); std::vector<float> ref = readf(path, (size_t)LROWS * DM); cmp("x1", out.data(), ref.data(), ref.size()); }
        if (s == 9) { snprintf(path, sizeof path, "%s/dbg_h1.bin", dir); std::vector<float> ref = readf(path, (size_t)ROWS * DM); std::vector<float> mine((size_t)ROWS * DM); const bf16_t* H = (const bf16_t*)(ws.data() + WS_H);
            for (int b = 0; b < NB; ++b) for (int j = 0; j < SEQ + CTX; ++j) { size_t r = j < SEQ ? (size_t)b * SEQ + j : LROWS + (size_t)b * CTX + j - SEQ; for (int c = 0; c < DM; ++c) mine[((size_t)b * (SEQ + CTX) + j) * DM + c] = bf2f(H[r * DM + c]); }
            cmp("h1", mine.data(), ref.data(), mine.size()); }
        if (s == 12) {
            snprintf(path, sizeof path, "%s/dbg_q1.bin", dir); std::vector<float> ref = readf(path, (size_t)LROWS * 1536); std::vector<float> mine((size_t)LROWS * 1536); const bf16_t* Q = (const bf16_t*)(ws.data() + WS_Q1);
            for (size_t r = 0; r < (size_t)LROWS; ++r) for (int c = 0; c < 1536; ++c) { int h = c / 96, w = c % 96; int oc = h * 96 + (w < 64 ? w : 64 + pe_orig(w - 64)); mine[r * 1536 + oc] = bf2f(Q[r * 1536 + c]) / QSCALE1; }
            cmp("q1", mine.data(), ref.data(), mine.size()); }
        if (s == 15) { snprintf(path, sizeof path, "%s/dbg_x2.bin", dir); std::vector<float> ref = readf(path, (size_t)LROWS * DM); cmp("x2", out.data(), ref.data(), ref.size()); }
    }
    snprintf(path, sizeof path, "%s/out.bin", dir); std::vector<float> ref = readf(path, (size_t)LROWS * DM); cmp("out", out.data(), ref.data(), ref.size());
    return 0;
}
#endif
```

```cpp
#ifndef HOST_TEST
#include <hip/hip_runtime.h>
#include <hip/hip_cooperative_groups.h>
#include <cstdio>
#define HD __device__ __forceinline__
#else
#include <cstdio>
#include <cstdlib>
#include <cstring>
#include <cmath>
#include <vector>
#define HD static inline
#endif
#include <cstdint>

#ifndef CFG_B
#define CFG_B 8
#endif
#ifndef CFG_S
#define CFG_S 2048
#endif
#ifndef CFG_C
#define CFG_C 256
#endif
constexpr int NB = CFG_B, SEQ = CFG_S, CTX = CFG_C, DM = 1024, GRIDW = 64;
constexpr int LROWS = NB * SEQ, CROWS = NB * CTX, ROWS = LROWS + CROWS;
constexpr int N_IN0 = 2816, N_IN1 = 1536;
constexpr int C_Q = 0, C_K = 512, C_V = 640, C_U = 768, C_VV = 1280, C_G = 1792;
constexpr float LOG2E = 1.4426950408889634f;
constexpr float QSCALE0 = 0.125f * LOG2E;
constexpr float QSCALE1 = 0.10206207261596577f * LOG2E;
constexpr float NORM_EPS = 1e-6f;

typedef unsigned short bf16_t;

constexpr size_t al(size_t x) { return (x + 4095) & ~(size_t)4095; }
constexpr size_t WS_CTL = 0;
constexpr size_t WS_WIN0 = 1u << 20;
constexpr size_t WS_WOUT0 = WS_WIN0 + al((size_t)N_IN0 * DM * 2);
constexpr size_t WS_WIN1 = WS_WOUT0 + al((size_t)DM * DM * 2);
constexpr size_t WS_WQB = WS_WIN1 + al((size_t)N_IN1 * DM * 2);
constexpr size_t WS_WKVB = WS_WQB + al((size_t)1536 * 256 * 2);
constexpr size_t WS_WOUT1 = WS_WKVB + al((size_t)2048 * 256 * 2);
constexpr size_t WS_WS = WS_WOUT1 + al((size_t)DM * DM * 2);
constexpr size_t WS_MOD = WS_WS + al((size_t)8 * 128 * 128 * 2);
constexpr size_t WS_ROPE0 = WS_MOD + al((size_t)2 * 9 * 3072 * 4);
constexpr size_t WS_ROPE1 = WS_ROPE0 + al((size_t)SEQ * 32 * 2 * 4);
constexpr size_t WS_VVP = WS_ROPE1 + al((size_t)SEQ * 16 * 2 * 4);
constexpr size_t WS_QSP = WS_VVP + al((size_t)ROWS * 16 * 4);
constexpr size_t WS_KVSP = WS_QSP + al((size_t)LROWS * 4 * 4);
constexpr size_t WS_KPE = WS_KVSP + al((size_t)ROWS * 4 * 4);
constexpr size_t WS_KVA = WS_KPE + al((size_t)ROWS * 32 * 2);
constexpr size_t WS_X1C = WS_KVA + al((size_t)ROWS * 256 * 2);
constexpr size_t WS_H = WS_X1C + al((size_t)CROWS * DM * 4);
constexpr size_t WS_K1N = WS_H;
constexpr size_t WS_P0 = WS_H + al((size_t)ROWS * DM * 2);
constexpr size_t WS_Q1 = WS_P0;
constexpr size_t WS_G1 = WS_Q1 + al((size_t)LROWS * 1536 * 2);
constexpr size_t WS_QA = WS_G1 + al((size_t)LROWS * DM * 2);
constexpr size_t WS_MIX = WS_P0 + al((size_t)ROWS * N_IN0 * 2);
constexpr size_t WS_V1 = WS_MIX + al((size_t)ROWS * DM * 2);
constexpr size_t WS_END = WS_V1 + al((size_t)ROWS * DM * 2);
static_assert(WS_QA + (size_t)LROWS * 256 * 2 <= WS_MIX, "layer-1 overlay fits in P0");
static_assert(WS_END <= (size_t)256 << 20, "workspace fits in 256 MiB");

struct Params {
    const float *x, *c, *ctx, *c_ctx, *norm_g, *w_ada, *b_ada, *w_in0, *sink0, *gm_ln_g, *gm_ln_b, *gm_ws, *gm_bs, *w_out0,
        *w_in1, *q_norm, *w_qb, *kv_norm, *w_kvb, *w_out1, *final_g;
    float* out;
    unsigned char* ws;
};

HD float bf2f(bf16_t v) { unsigned u = (unsigned)v << 16; float f; memcpy(&f, &u, 4); return f; }
HD bf16_t f2bf(float f) { unsigned u; memcpy(&u, &f, 4); return (bf16_t)((u + 0x7fffu + ((u >> 16) & 1u)) >> 16); }
HD float silu_f(float v) { return v / (1.0f + expf(-v)); }
HD float gelu_f(float v) { return 0.5f * v * (1.0f + erff(v * 0.70710678118654752f)); }
HD int pe_orig(int p) { return p < 8 ? p : (p < 16 ? p + 8 : (p < 24 ? p - 8 : p)); }

#define WSP(T, off) ((T*)(p.ws + (off)))

constexpr long W_ITEMS0 = (long)N_IN0 * DM, W_ITEMS1 = (long)DM * DM, W_ITEMS2 = (long)N_IN1 * DM, W_ITEMS3 = 1536L * 256, W_ITEMS4 = 2048L * 256,
               W_ITEMS5 = (long)DM * DM, W_ITEMS6 = 8L * 128 * 128;
constexpr long W_ITEMS = W_ITEMS0 + W_ITEMS1 + W_ITEMS2 + W_ITEMS3 + W_ITEMS4 + W_ITEMS5 + W_ITEMS6;
HD void nk_weights(const Params& p, long it) {
    if (it < W_ITEMS0) { int n = (int)(it / DM), k = (int)(it % DM); WSP(bf16_t, WS_WIN0)[it] = f2bf(p.w_in0[(size_t)k * N_IN0 + n]); return; } it -= W_ITEMS0;
    if (it < W_ITEMS1) { int n = (int)(it / DM), k = (int)(it % DM); WSP(bf16_t, WS_WOUT0)[it] = f2bf(p.w_out0[(size_t)k * DM + n]); return; } it -= W_ITEMS1;
    if (it < W_ITEMS2) { int n = (int)(it / DM), k = (int)(it % DM); float v = 0.f;
        if (n < 416) v = p.w_in1[(size_t)k * 1440 + (n < 384 ? n : 384 + pe_orig(n - 384))]; else if (n >= 512) v = p.w_in1[(size_t)k * 1440 + n - 96];
        WSP(bf16_t, WS_WIN1)[it] = f2bf(v); return; } it -= W_ITEMS2;
    if (it < W_ITEMS3) { int n = (int)(it / 256), k = (int)(it % 256); int h = n / 96, w = n % 96; int oc = h * 96 + (w < 64 ? w : 64 + pe_orig(w - 64));
        WSP(bf16_t, WS_WQB)[it] = f2bf(p.w_qb[(size_t)k * 1536 + oc] * p.q_norm[k]); return; } it -= W_ITEMS3;
    if (it < W_ITEMS4) { int n = (int)(it / 256), k = (int)(it % 256); int nn = n & 1023, h = nn >> 6, d = nn & 63; int oc = h * 128 + d + (n >= 1024 ? 64 : 0);
        WSP(bf16_t, WS_WKVB)[it] = k < 128 ? f2bf(p.w_kvb[(size_t)k * 2048 + oc] * p.kv_norm[k]) : (bf16_t)0; return; } it -= W_ITEMS4;
    if (it < W_ITEMS5) { int n = (int)(it / DM), k = (int)(it % DM); WSP(bf16_t, WS_WOUT1)[it] = f2bf(p.w_out1[(size_t)k * DM + n]); return; } it -= W_ITEMS5;
    WSP(bf16_t, WS_WS)[it] = f2bf(p.gm_ws[it]);
}
constexpr long ROPE_ITEMS = (long)SEQ * 48;
HD void nk_rope(const Params& p, long it) {
    int s = (int)(it / 48), t = (int)(it % 48); float pr = (float)(s / GRIDW), pc = (float)(s % GRIDW);
    if (t < 32) { int j = t & 15; float inv = exp2f(-(float)j * (13.287712379549449f / 16.0f)); float a = (t < 16 ? pr : pc) * inv;
        float* o = WSP(float, WS_ROPE0) + ((size_t)s * 32 + t) * 2; o[0] = cosf(a); o[1] = sinf(a); }
    else { int u = t - 32, j = u & 7; float inv = exp2f(-(float)j * (13.287712379549449f / 8.0f)); float a = (u < 8 ? pr : pc) * inv;
        float* o = WSP(float, WS_ROPE1) + ((size_t)s * 16 + u) * 2; o[0] = cosf(a); o[1] = sinf(a); }
}
constexpr long ADA_ITEMS = 2L * 3072;
HD void nk_adaln(const Params& p, long it) {
    int l = (int)(it / 3072), n = (int)(it % 3072); float acc[9];
#pragma unroll
    for (int r = 0; r < 9; ++r) acc[r] = 0.f;
    const float* w = p.w_ada + (size_t)l * DM * 3072 + n;
    for (int k = 0; k < DM; ++k) { float wv = w[(size_t)k * 3072];
#pragma unroll
        for (int r = 0; r < 9; ++r) { float cv = (r < 8) ? (r < NB ? p.c[r * DM + k] : 0.f) : p.c_ctx[k]; acc[r] += silu_f(cv) * wv; } }
    float bb = p.b_ada[l * 3072 + n];
#pragma unroll
    for (int r = 0; r < 9; ++r) WSP(float, WS_MOD)[((size_t)l * 9 + r) * 3072 + n] = acc[r] + bb;
}
HD void nk_modnorm(const Params& p, long r, int layer) {
    const float* src; int mr;
    if (r < LROWS) { src = (layer == 0 ? p.x : p.out) + (size_t)r * DM; mr = (int)(r / SEQ); }
    else { src = (layer == 0 ? p.ctx : WSP(float, WS_X1C)) + (size_t)(r - LROWS) * DM; mr = 8; }
    float ss = 0.f; for (int k = 0; k < DM; ++k) ss += src[k] * src[k];
    float rstd = 1.0f / sqrtf(ss / DM + NORM_EPS);
    const float* md = WSP(float, WS_MOD) + ((size_t)layer * 9 + mr) * 3072; const float* g = p.norm_g + layer * DM;
    bf16_t* o = WSP(bf16_t, WS_H) + (size_t)r * DM;
    for (int k = 0; k < DM; ++k) o[k] = f2bf(src[k] * rstd * g[k] * (1.0f + md[1024 + k]) + md[k]);
}
HD float nk_dot(const bf16_t* a, const bf16_t* b, int K) { float s = 0.f; for (int k = 0; k < K; ++k) s += bf2f(a[k]) * bf2f(b[k]); return s; }
constexpr long IN0_ITEMS = (long)ROWS * N_IN0;
HD void nk_in0(const Params& p, long it) {
    long r = it / N_IN0; int c = (int)(it % N_IN0);
    const bf16_t* a = WSP(bf16_t, WS_H) + (size_t)r * DM; const bf16_t* W = WSP(bf16_t, WS_WIN0);
    float v = nk_dot(a, W + (size_t)c * DM, DM), o;
    if (c < C_V) {
        if (r < LROWS) { int d = c & 63, t = d & 15, second = (d >> 4) & 1, ax = d >> 5; int pc = second ? c - 16 : c + 16;
            float v2 = nk_dot(a, W + (size_t)pc * DM, DM); int s = (int)(r % SEQ); const float* cs = WSP(float, WS_ROPE0) + ((size_t)s * 32 + ax * 16 + t) * 2;
            o = second ? (v2 * cs[1] + v * cs[0]) : (v * cs[0] - v2 * cs[1]); }
        else o = v;
        if (c < C_K) o *= QSCALE0;
    } else if (c < C_U) o = v;
    else if (c < C_G) o = gelu_f(v);
    else o = silu_f(v);
    WSP(bf16_t, WS_P0)[it] = f2bf(o);
}
constexpr long VVP_ITEMS = (long)ROWS * 8;
HD void nk_vvp(const Params& p, long it) {
    long r = it / 8; int j = (int)(it % 8); const bf16_t* v = WSP(bf16_t, WS_P0) + (size_t)r * N_IN0 + C_VV + 64 * j; float s = 0.f, q = 0.f;
    for (int i = 0; i < 64; ++i) { float f = bf2f(v[i]); s += f; q += f * f; }
    float* o = WSP(float, WS_VVP) + it * 2; o[0] = s; o[1] = q;
}
constexpr long ATT0_ITEMS = (long)ROWS * 8;
HD void nk_attn0(const Params& p, long it) {
    int h = (int)(it / ROWS); long r = it % ROWS; int hk = h >> 2;
    const bf16_t* P0 = WSP(bf16_t, WS_P0); const bf16_t* qp = P0 + (size_t)r * N_IN0 + C_Q + 64 * h;
    float q[64], o[64];
#pragma unroll
    for (int d = 0; d < 64; ++d) { q[d] = bf2f(qp[d]); o[d] = 0.f; }
    float m = -1e30f, l = 0.f;
    int b, j0 = 0, j1 = 0; long cbase;
    if (r < LROWS) { b = (int)(r / SEQ); int s = (int)(r % SEQ); j0 = s - 128 < 0 ? 0 : s - 128; j1 = s + 128 > SEQ - 1 ? SEQ - 1 : s + 128; }
    else { b = (int)((r - LROWS) / CTX); j0 = 1; j1 = 0; }
    cbase = LROWS + (long)b * CTX;
    const int nloc = j1 - j0 + 1 > 0 ? j1 - j0 + 1 : 0;
    for (int t = 0; t < nloc + CTX; ++t) {
        long kr = t < nloc ? (long)b * SEQ + j0 + t : cbase + (t - nloc);
        const bf16_t* kp = P0 + (size_t)kr * N_IN0 + C_K + 64 * hk; const bf16_t* vp = P0 + (size_t)kr * N_IN0 + C_V + 64 * hk;
        float s = 0.f;
#pragma unroll
        for (int d = 0; d < 64; ++d) s += q[d] * bf2f(kp[d]);
        float mn = s > m ? s : m, a = exp2f(m - mn), pp = exp2f(s - mn); l = l * a + pp; m = mn;
#pragma unroll
        for (int d = 0; d < 64; ++d) o[d] = o[d] * a + pp * bf2f(vp[d]);
    }
    { float s = p.sink0[h] * LOG2E; float mn = s > m ? s : m, a = exp2f(m - mn), pp = exp2f(s - mn); l = l * a + pp;
#pragma unroll
      for (int d = 0; d < 64; ++d) o[d] *= a; }
    const bf16_t* gp = P0 + (size_t)r * N_IN0 + C_G + 64 * h; bf16_t* op = WSP(bf16_t, WS_MIX) + (size_t)r * DM + 64 * h; float rl = 1.0f / l;
#pragma unroll
    for (int d = 0; d < 64; ++d) op[d] = f2bf(o[d] * rl * bf2f(gp[d]));
}
constexpr long GMLP_ITEMS = (long)ROWS * 512;
HD void nk_gmlp(const Params& p, long it) {
    long r = it / 512; int c = (int)(it % 512), g = c >> 6, pp = (int)(r & 127); long r0 = r - pp;
    const bf16_t* P0 = WSP(bf16_t, WS_P0); const bf16_t* W = WSP(bf16_t, WS_WS) + ((size_t)g * 128 + pp) * 128; const float* vvp = WSP(float, WS_VVP);
    float lg = p.gm_ln_g[c], lb = p.gm_ln_b[c], s = 0.f;
    for (int q = 0; q < 128; ++q) { const float* pt = vvp + (size_t)(r0 + q) * 16; float sm = 0.f, sq = 0.f;
        for (int j = 0; j < 8; ++j) { sm += pt[2 * j]; sq += pt[2 * j + 1]; }
        float mean = sm * (1.0f / 512), var = sq * (1.0f / 512) - mean * mean, rstd = 1.0f / sqrtf(var + NORM_EPS);
        float vn = bf2f(f2bf((bf2f(P0[(size_t)(r0 + q) * N_IN0 + C_VV + c]) - mean) * rstd * lg + lb));
        s += bf2f(W[q]) * vn; }
    s += p.gm_bs[g * 128 + pp];
    float u = bf2f(P0[(size_t)r * N_IN0 + C_U + c]), gt = bf2f(P0[(size_t)r * N_IN0 + C_G + 512 + c]);
    WSP(bf16_t, WS_MIX)[(size_t)r * DM + 512 + c] = f2bf(u * s * gt);
}
constexpr long OUT0_ITEMS = (long)ROWS * DM;
HD void nk_out0(const Params& p, long it) {
    long r = it / DM; int c = (int)(it % DM);
    float y = nk_dot(WSP(bf16_t, WS_MIX) + (size_t)r * DM, WSP(bf16_t, WS_WOUT0) + (size_t)c * DM, DM);
    if (r < LROWS) { int b = (int)(r / SEQ); p.out[it] = p.x[it] + WSP(float, WS_MOD)[(size_t)b * 3072 + 2048 + c] * y; }
    else { size_t ci = (size_t)(r - LROWS) * DM + c; WSP(float, WS_X1C)[ci] = p.ctx[ci] + WSP(float, WS_MOD)[(size_t)8 * 3072 + 2048 + c] * y; }
}
constexpr long IN1_ITEMS = (long)ROWS * N_IN1;
HD void nk_in1(const Params& p, long it) {
    long r = it / N_IN1; int c = (int)(it % N_IN1);
    if (c >= 384 && c < 512) WSP(bf16_t, WS_KVA)[(size_t)r * 256 + 128 + c - 384] = 0;
    if (c >= 416 && c < 512) return;
    if (r >= LROWS && (c < 256 || c >= 416)) return;
    const bf16_t* a = WSP(bf16_t, WS_H) + (size_t)r * DM; const bf16_t* W = WSP(bf16_t, WS_WIN1);
    float v = nk_dot(a, W + (size_t)c * DM, DM);
    if (c < 256) WSP(bf16_t, WS_QA)[(size_t)r * 256 + c] = f2bf(v);
    else if (c < 384) WSP(bf16_t, WS_KVA)[(size_t)r * 256 + c - 256] = f2bf(v);
    else if (c < 416) { int pp = c - 384; float o = v;
        if (r < LROWS) { int second = pp >> 4, t = pp & 15; int pc = second ? c - 16 : c + 16; float v2 = nk_dot(a, W + (size_t)pc * DM, DM);
            int s = (int)(r % SEQ); const float* cs = WSP(float, WS_ROPE1) + ((size_t)s * 16 + t) * 2;
            o = second ? (v2 * cs[1] + v * cs[0]) : (v * cs[0] - v2 * cs[1]); }
        WSP(bf16_t, WS_KPE)[(size_t)r * 32 + pp] = f2bf(o); }
    else WSP(bf16_t, WS_G1)[(size_t)r * DM + c - 512] = f2bf(silu_f(v));
}
constexpr long SSP_ITEMS = (long)ROWS * 8;
HD void nk_ssp(const Params& p, long it) {
    long r = it / 8; int j = (int)(it % 8);
    if (j < 4) { if (r >= LROWS) return; const bf16_t* v = WSP(bf16_t, WS_QA) + (size_t)r * 256 + 64 * j; float q = 0.f; for (int i = 0; i < 64; ++i) { float f = bf2f(v[i]); q += f * f; }
        WSP(float, WS_QSP)[r * 4 + j] = q; }
    else { j -= 4; const bf16_t* v = WSP(bf16_t, WS_KVA) + (size_t)r * 256 + 32 * j; float q = 0.f; for (int i = 0; i < 32; ++i) { float f = bf2f(v[i]); q += f * f; }
        WSP(float, WS_KVSP)[r * 4 + j] = q; }
}
constexpr long QB_ITEMS = (long)LROWS * 1536;
HD void nk_qb(const Params& p, long it) {
    long r = it / 1536; int c = (int)(it % 1536); int w = c % 96;
    const bf16_t* a = WSP(bf16_t, WS_QA) + (size_t)r * 256; const bf16_t* W = WSP(bf16_t, WS_WQB);
    const float* sp = WSP(float, WS_QSP) + r * 4; float rstd = 1.0f / sqrtf((sp[0] + sp[1] + sp[2] + sp[3]) * (1.0f / 256) + NORM_EPS);
    float v = nk_dot(a, W + (size_t)c * 256, 256) * rstd, o = v;
    if (w >= 64) { int pp = w - 64, second = pp >> 4, t = pp & 15; int pc = second ? c - 16 : c + 16; float v2 = nk_dot(a, W + (size_t)pc * 256, 256) * rstd;
        int s = (int)(r % SEQ); const float* cs = WSP(float, WS_ROPE1) + ((size_t)s * 16 + t) * 2;
        o = second ? (v2 * cs[1] + v * cs[0]) : (v * cs[0] - v2 * cs[1]); }
    WSP(bf16_t, WS_Q1)[it] = f2bf(o * QSCALE1);
}
constexpr long KVB_ITEMS = (long)ROWS * 2048;
HD void nk_kvb(const Params& p, long it) {
    long r = it / 2048; int c = (int)(it % 2048);
    const float* sp = WSP(float, WS_KVSP) + r * 4; float rstd = 1.0f / sqrtf((sp[0] + sp[1] + sp[2] + sp[3]) * (1.0f / 128) + NORM_EPS);
    float v = nk_dot(WSP(bf16_t, WS_KVA) + (size_t)r * 256, WSP(bf16_t, WS_WKVB) + (size_t)c * 256, 256) * rstd;
    if (c < 1024) WSP(bf16_t, WS_K1N)[(size_t)r * DM + c] = f2bf(v); else WSP(bf16_t, WS_V1)[(size_t)r * DM + c - 1024] = f2bf(v);
}
constexpr long ATT1_ITEMS = (long)LROWS * 16;
HD void nk_attn1(const Params& p, long it) {
    int h = (int)(it / LROWS); long r = it % LROWS; int b = (int)(r / SEQ);
    const bf16_t* qp = WSP(bf16_t, WS_Q1) + (size_t)r * 1536 + 96 * h;
    float q[96], o[64];
#pragma unroll
    for (int d = 0; d < 96; ++d) q[d] = bf2f(qp[d]);
#pragma unroll
    for (int d = 0; d < 64; ++d) o[d] = 0.f;
    float m = -1e30f, l = 0.f;
    for (int t = 0; t < SEQ + CTX; ++t) {
        long kr = t < SEQ ? (long)b * SEQ + t : LROWS + (long)b * CTX + (t - SEQ);
        const bf16_t* kn = WSP(bf16_t, WS_K1N) + (size_t)kr * DM + 64 * h; const bf16_t* kp = WSP(bf16_t, WS_KPE) + (size_t)kr * 32; const bf16_t* vp = WSP(bf16_t, WS_V1) + (size_t)kr * DM + 64 * h;
        float s = 0.f;
#pragma unroll
        for (int d = 0; d < 64; ++d) s += q[d] * bf2f(kn[d]);
#pragma unroll
        for (int d = 0; d < 32; ++d) s += q[64 + d] * bf2f(kp[d]);
        float mn = s > m ? s : m, a = exp2f(m - mn), pp = exp2f(s - mn); l = l * a + pp; m = mn;
#pragma unroll
        for (int d = 0; d < 64; ++d) o[d] = o[d] * a + pp * bf2f(vp[d]);
    }
    const bf16_t* gp = WSP(bf16_t, WS_G1) + (size_t)r * DM + 64 * h; bf16_t* op = WSP(bf16_t, WS_MIX) + (size_t)r * DM + 64 * h; float rl = 1.0f / l;
#pragma unroll
    for (int d = 0; d < 64; ++d) op[d] = f2bf(o[d] * rl * bf2f(gp[d]));
}
constexpr long OUT1_ITEMS = (long)LROWS * DM;
HD void nk_out1(const Params& p, long it) {
    long r = it / DM; int c = (int)(it % DM); int b = (int)(r / SEQ);
    float y = nk_dot(WSP(bf16_t, WS_MIX) + (size_t)r * DM, WSP(bf16_t, WS_WOUT1) + (size_t)c * DM, DM);
    p.out[it] = p.out[it] + WSP(float, WS_MOD)[((size_t)9 + b) * 3072 + 2048 + c] * y;
}
HD void nk_final(const Params& p, long r) {
    float* o = p.out + (size_t)r * DM; float ss = 0.f; for (int k = 0; k < DM; ++k) ss += o[k] * o[k];
    float rstd = 1.0f / sqrtf(ss / DM + NORM_EPS);
    for (int k = 0; k < DM; ++k) o[k] = o[k] * rstd * p.final_g[k];
}

constexpr int N_STAGES = 16;
#ifndef HOST_TEST
__host__ __device__ inline
#else
static inline
#endif
long stage_items(int s) {
    switch (s) { case 0: return W_ITEMS; case 1: return ROPE_ITEMS; case 2: return ADA_ITEMS; case 3: return ROWS; case 4: return IN0_ITEMS; case 5: return VVP_ITEMS;
        case 6: return ATT0_ITEMS; case 7: return GMLP_ITEMS; case 8: return OUT0_ITEMS; case 9: return ROWS; case 10: return IN1_ITEMS; case 11: return SSP_ITEMS;
        case 12: return QB_ITEMS; case 13: return KVB_ITEMS; case 14: return ATT1_ITEMS; case 15: return OUT1_ITEMS; default: return LROWS; }
}
HD void stage_item(const Params& p, int s, long it) {
    switch (s) { case 0: nk_weights(p, it); break; case 1: nk_rope(p, it); break; case 2: nk_adaln(p, it); break; case 3: nk_modnorm(p, it, 0); break; case 4: nk_in0(p, it); break;
        case 5: nk_vvp(p, it); break; case 6: nk_attn0(p, it); break; case 7: nk_gmlp(p, it); break; case 8: nk_out0(p, it); break; case 9: nk_modnorm(p, it, 1); break;
        case 10: nk_in1(p, it); break; case 11: nk_ssp(p, it); break; case 12: nk_qb(p, it); break; case 13: nk_kvb(p, it); break; case 14: nk_attn1(p, it); break;
        case 15: nk_out1(p, it); break; default: nk_final(p, it); break; }
}
HD bool stage_sync_after(int s) { return !(s == 0 || s == 1 || s == 6 || s == 12); }

#ifndef HOST_TEST
#include <hip/hip_bf16.h>
namespace pg8 {
#define PG8_LAS __attribute__((address_space(3)))
typedef unsigned short bf16_t;
typedef short bf16x8 __attribute__((ext_vector_type(8)));
typedef float f32x4 __attribute__((ext_vector_type(4)));
typedef unsigned u32x4 __attribute__((ext_vector_type(4)));
constexpr int BM = 256, BK = 64, HALF = 128, HTB = HALF * BK * 2  , STAGE_BYTES = 8 * HTB, NXCD = 8, WGM = 8;

__host__ __device__ __forceinline__ int lds_byte(int r, int c) { const int st = (r >> 4) * 2 + (c >> 5), rr = r & 15, cc = c & 31, ob = rr * 64 + cc * 2; return st * 1024 + (ob ^ (((ob >> 9) & 1) << 5)); }
__host__ __device__ __forceinline__ void stage_rc(int b, int& R, int& C) { const int st = b / 1024, sb = b % 1024, swz = sb ^ (((sb >> 9) & 1) << 5); R = (st >> 1) * 16 + swz / 64; C = (st & 1) * 32 + (swz % 64) / 2; }
__host__ __device__ __forceinline__ int perm32(int rho) { const int n = rho >> 4, i = rho & 15; return 8 * (i >> 2) + 4 * n + (i & 3); }

struct Unit { int pm, pn; };
struct Gemm { const bf16_t* A; const bf16_t* Bt; int M, N, K; };
struct StaticOrder {
    int nM, nN, nwg, G, c;
    __host__ __device__ void init(int M, int N, int G_, int c_) { nM = M / BM; nN = N / BM; nwg = nM * nN; G = G_; c = c_; }
    __host__ __device__ bool next(int i, Unit& u) const {
        const long L = (long)i * G + c; if (L >= nwg) return false;
        int wgid = (int)L; { const int q = nwg / NXCD, r = nwg % NXCD, xcd = wgid % NXCD, off = wgid / NXCD; wgid = (xcd < r ? xcd * (q + 1) : r * (q + 1) + (xcd - r) * q) + off; }
        const int nig = WGM * nN, gid = wgid / nig, fm = gid * WGM, gsz = (nM - fm) < WGM ? (nM - fm) : WGM;
        u.pm = fm + ((wgid % nig) % gsz); u.pn = (wgid % nig) / gsz; return true;
    }
    __device__ __forceinline__ void a_ready(const Unit&) const {}
    __device__ __forceinline__ void done(const Unit&) const {}
};
__device__ __forceinline__ unsigned cvt_pk_bf16(float lo, float hi) { unsigned r; asm volatile("v_cvt_pk_bf16_f32 %0, %1, %2" : "=v"(r) : "v"(lo), "v"(hi)); return r; }
typedef float f32x2 __attribute__((ext_vector_type(2)));
template <class Epi, class Sched, bool ALIGN_EPI = false, bool SP2 = false>
__device__ __forceinline__ void gemm_phase(PG8_LAS unsigned char* lds, const Gemm g, const Sched& S, const Epi& E) {
    int tid_ = threadIdx.x; asm volatile("" : "+v"(tid_));
    const int tid = tid_, wid = __builtin_amdgcn_readfirstlane(tid >> 6), lane = tid & 63, wr = wid >> 2, wc = wid & 3, fr = lane & 15, fq = lane >> 4;
    const int K = g.K, nt = K / BK;
    unsigned voffA[2], voffB[2];
#pragma unroll
    for (int i = 0; i < 2; ++i) { int R, C; stage_rc(tid * 16 + i * 8192, R, C); const int Rb = Epi::PERM ? ((R & ~31) + perm32(R & 31)) : R;
        voffA[i] = (unsigned)(R * K + C) * 2u; voffB[i] = (unsigned)(Rb * K + C) * 2u; }
    const size_t kstep = (size_t)(BK * 2);
    const size_t hstep = (size_t)HALF * K * 2;
    const size_t tstep = 2 * hstep;
    const unsigned ldsw = (unsigned)wid * 1024u;
    const int aoff = lds_byte(wr * 64 + fr, fq * 8), boff = lds_byte(wc * 32 + fr, fq * 8);
#define PG8_SA(b, h) (((b) * 2 + (h)) * HTB)
#define PG8_SB(b, h) ((4 + (b) * 2 + (h)) * HTB)
#define PG8_STAGE(bufoff, gbase, voff) do { _Pragma("unroll") for (int _i = 0; _i < 2; ++_i) \
        __builtin_amdgcn_global_load_lds((const unsigned*)((const char*)(gbase) + (voff)[_i]), (PG8_LAS unsigned*)(lds + (bufoff) + ldsw + _i * 8192), 16, 0, 0); } while (0)
#define PG8_LDA(dst, b, h) do { _Pragma("unroll") for (int m = 0; m < 4; ++m) _Pragma("unroll") for (int k = 0; k < 2; ++k) dst[m][k] = *(const PG8_LAS bf16x8*)(lds + PG8_SA(b, h) + aoff + m * 2048 + k * 1024); } while (0)
#define PG8_LDB(dst, b, h) do { _Pragma("unroll") for (int n = 0; n < 2; ++n) _Pragma("unroll") for (int k = 0; k < 2; ++k) dst[n][k] = *(const PG8_LAS bf16x8*)(lds + PG8_SB(b, h) + boff + n * 2048 + k * 1024); } while (0)
#define PG8_MMA(ai, bj, At, Bt) do { __builtin_amdgcn_s_setprio(1); _Pragma("unroll") for (int m = 0; m < 4; ++m) _Pragma("unroll") for (int n = 0; n < 2; ++n) _Pragma("unroll") for (int k = 0; k < 2; ++k) \
        acc[ai][bj][m][n] = __builtin_amdgcn_mfma_f32_16x16x32_bf16(Bt[n][k], At[m][k], acc[ai][bj][m][n], 0, 0, 0); __builtin_amdgcn_s_setprio(0); } while (0)
#define PG8_WAIT_V(n) asm volatile("s_waitcnt vmcnt(" #n ")" ::: "memory")
#define PG8_WAIT_L(n) asm volatile("s_waitcnt lgkmcnt(" #n ")" ::: "memory")
#define PG8_BAR __builtin_amdgcn_s_barrier()
#define PG8_SCHED __builtin_amdgcn_sched_barrier(0)
    Unit cur, nxt; int ui = 0;
    if (!S.next(0, cur)) return;
    f32x4 acc[2][2][4][2];
#pragma unroll
    for (int a = 0; a < 2; ++a)
#pragma unroll
        for (int b = 0; b < 2; ++b)
#pragma unroll
            for (int m = 0; m < 4; ++m)
#pragma unroll
                for (int n = 0; n < 2; ++n) acc[a][b][m][n] = (f32x4){0.f, 0.f, 0.f, 0.f};
    bf16x8 At[4][2], B0[2][2], B1[2][2];
    const char* cA = (const char*)g.A + (size_t)cur.pm * tstep; const char* cB = (const char*)g.Bt + (size_t)cur.pn * tstep;
    S.a_ready(cur);
    if constexpr (SP2) {
        PG8_STAGE(PG8_SB(0, 0), cB, voffB); PG8_STAGE(PG8_SB(0, 1), cB + hstep, voffB); PG8_STAGE(PG8_SA(0, 0), cA, voffA); PG8_STAGE(PG8_SA(0, 1), cA + hstep, voffA);
        if (wr == 1) PG8_BAR;
        PG8_WAIT_V(2); PG8_BAR;
        PG8_STAGE(PG8_SB(1, 0), cB + kstep, voffB); PG8_STAGE(PG8_SA(1, 0), cA + kstep, voffA); PG8_STAGE(PG8_SB(1, 1), cB + hstep + kstep, voffB);
        PG8_WAIT_V(6); PG8_BAR;
    } else {
        PG8_STAGE(PG8_SB(0, 0), cB, voffB); PG8_STAGE(PG8_SA(0, 0), cA, voffA); PG8_STAGE(PG8_SB(0, 1), cB + hstep, voffB); PG8_STAGE(PG8_SA(0, 1), cA + hstep, voffA);
        if (wr == 1) PG8_BAR;
        PG8_WAIT_V(4); PG8_BAR;
        PG8_STAGE(PG8_SB(1, 0), cB + kstep, voffB); PG8_STAGE(PG8_SA(1, 0), cA + kstep, voffA); PG8_STAGE(PG8_SB(1, 1), cB + hstep + kstep, voffB);
        PG8_WAIT_V(6); PG8_BAR;
    }
    for (;;) {
        const bool has_next = S.next(ui + 1, nxt);
        const char* nA = has_next ? (const char*)g.A + (size_t)nxt.pm * tstep : cA; const char* nB = has_next ? (const char*)g.Bt + (size_t)nxt.pn * tstep : cB;
        for (int t = 0; t < nt; t += 2) {
            const bool last = (t == nt - 2);
            const char* a1 = cA + (size_t)(t + 1) * kstep;
            const char* a2 = last ? nA : cA + (size_t)(t + 2) * kstep; const char* b2 = last ? nB : cB + (size_t)(t + 2) * kstep;
            const char* a3 = a2 + kstep; const char* b3 = b2 + kstep;
            if (last && has_next) S.a_ready(nxt);
            if constexpr (SP2) {
            PG8_LDB(B0, 0, 0); PG8_LDB(B1, 0, 1); PG8_SCHED; PG8_LDA(At, 0, 0); PG8_STAGE(PG8_SA(1, 1), a1 + hstep, voffA);
            PG8_WAIT_V(8); PG8_WAIT_L(0); PG8_BAR; PG8_MMA(0, 0, At, B0); PG8_MMA(0, 1, At, B1); PG8_BAR; PG8_SCHED;
            PG8_LDA(At, 0, 1); PG8_STAGE(PG8_SB(0, 0), b2, voffB); PG8_STAGE(PG8_SB(0, 1), b2 + hstep, voffB); PG8_STAGE(PG8_SA(0, 0), a2, voffA);
            PG8_WAIT_V(8); PG8_WAIT_L(0); PG8_BAR; PG8_MMA(1, 0, At, B0); PG8_MMA(1, 1, At, B1); PG8_BAR; PG8_SCHED;
            PG8_LDB(B0, 1, 0); PG8_LDB(B1, 1, 1); PG8_SCHED; PG8_LDA(At, 1, 0); PG8_STAGE(PG8_SA(0, 1), a2 + hstep, voffA);
            PG8_WAIT_V(8); PG8_WAIT_L(0); PG8_BAR; PG8_MMA(0, 0, At, B0); PG8_MMA(0, 1, At, B1); PG8_BAR; PG8_SCHED;
            PG8_LDA(At, 1, 1); PG8_STAGE(PG8_SB(1, 0), b3, voffB); PG8_STAGE(PG8_SB(1, 1), b3 + hstep, voffB); PG8_STAGE(PG8_SA(1, 0), a3, voffA);
            PG8_WAIT_V(8); PG8_WAIT_L(0); PG8_BAR; PG8_MMA(1, 0, At, B0); PG8_MMA(1, 1, At, B1); PG8_BAR; PG8_SCHED;
            } else {
            PG8_LDB(B0, 0, 0); PG8_SCHED; PG8_LDA(At, 0, 0); PG8_STAGE(PG8_SA(1, 1), a1 + hstep, voffA);
            PG8_WAIT_L(8); PG8_BAR; PG8_WAIT_L(0); PG8_MMA(0, 0, At, B0); PG8_BAR; PG8_SCHED;
            PG8_LDB(B1, 0, 1); PG8_STAGE(PG8_SB(0, 0), b2, voffB);
            PG8_BAR; PG8_WAIT_L(0); PG8_MMA(0, 1, At, B1); PG8_BAR;
            PG8_LDA(At, 0, 1); PG8_STAGE(PG8_SA(0, 0), a2, voffA);
            PG8_BAR; PG8_WAIT_L(0); PG8_MMA(1, 0, At, B0); PG8_BAR; PG8_SCHED;
            PG8_STAGE(PG8_SB(0, 1), b2 + hstep, voffB);
            PG8_WAIT_V(6); PG8_BAR; PG8_MMA(1, 1, At, B1); PG8_BAR;
            PG8_LDB(B0, 1, 0); PG8_SCHED; PG8_LDA(At, 1, 0); PG8_STAGE(PG8_SA(0, 1), a2 + hstep, voffA);
            PG8_WAIT_L(8); PG8_BAR; PG8_WAIT_L(0); PG8_MMA(0, 0, At, B0); PG8_BAR; PG8_SCHED;
            PG8_LDB(B1, 1, 1); PG8_STAGE(PG8_SB(1, 0), b3, voffB);
            PG8_BAR; PG8_WAIT_L(0); PG8_MMA(0, 1, At, B1); PG8_BAR;
            PG8_LDA(At, 1, 1); PG8_STAGE(PG8_SA(1, 0), a3, voffA);
            PG8_BAR; PG8_WAIT_L(0); PG8_MMA(1, 0, At, B0); PG8_BAR; PG8_SCHED;
            PG8_STAGE(PG8_SB(1, 1), b3 + hstep, voffB);
            PG8_WAIT_V(6); PG8_BAR; PG8_MMA(1, 1, At, B1); PG8_BAR;
            }
        }
        if constexpr (ALIGN_EPI) { if (wr == 0) PG8_BAR; }
        if constexpr (!Epi::AFTER_DRAIN) { E(acc, cur, wr, wc, fr, fq); S.done(cur); }
        if (!has_next) break;
#pragma unroll
        for (int a = 0; a < 2; ++a)
#pragma unroll
            for (int b = 0; b < 2; ++b)
#pragma unroll
                for (int m = 0; m < 4; ++m)
#pragma unroll
                    for (int n = 0; n < 2; ++n) acc[a][b][m][n] = (f32x4){0.f, 0.f, 0.f, 0.f};
        cur = nxt; cA = nA; cB = nB; ++ui;
        if constexpr (ALIGN_EPI) { if (wr == 1) PG8_BAR; }
    }
    PG8_WAIT_V(0);
    if constexpr (!ALIGN_EPI) { if (wr == 0) PG8_BAR; }
    PG8_BAR;
    if constexpr (Epi::AFTER_DRAIN) { E.fused(acc, cur, wr, wc, fr, fq, lds, wid, lane); S.done(cur); }
#undef PG8_SA
#undef PG8_SB
#undef PG8_STAGE
#undef PG8_LDA
#undef PG8_LDB
#undef PG8_MMA
#undef PG8_WAIT_V
#undef PG8_WAIT_L
#undef PG8_BAR
#undef PG8_SCHED
}
}
namespace pg8 {
struct ExtOrder : StaticOrder {
    int n_extra, pm0, pn_extra;
    __device__ __forceinline__ void init2(int M, int N, int G_, int c_, int n_extra_, int pm0_, int pn_extra_) { init(M, N, G_, c_); n_extra = n_extra_; pm0 = pm0_; pn_extra = pn_extra_; }
    __device__ __forceinline__ bool next(int i, Unit& u) const {
        const long L = (long)i * G + c; if (L < nwg) return StaticOrder::next(i, u);
        const long e = L - nwg; if (e >= n_extra) return false; u.pm = pm0 + (int)e; u.pn = pn_extra; return true;
    }
};
typedef unsigned u32x2 __attribute__((ext_vector_type(2)));
__device__ __forceinline__ f32x2 gelu_pk(f32x2 v) {
    const f32x2 av = __builtin_elementwise_abs(v), d = av * 0.2316418882f + 1.0f;
    f32x2 t; t.x = __builtin_amdgcn_rcpf(d.x); t.y = __builtin_amdgcn_rcpf(d.y);
    f32x2 q = t * 0.5307027145f + (-0.7265760135f); q = q * t + 0.7107068705f; q = q * t + (-0.142248368f); q = q * t + 0.127414796f; q = q * t;
    const f32x2 s = (v * v) * (-0.72134752044f);
    f32x2 e; e.x = __builtin_amdgcn_exp2f(s.x); e.y = __builtin_amdgcn_exp2f(s.y);
    const f32x2 m = v * (q * e), r = v - m;
    f32x2 o; o.x = v.x < 0.f ? m.x : r.x; o.y = v.y < 0.f ? m.y : r.y; return o;
}
__device__ __forceinline__ f32x4 gelu4(f32x4 v) { f32x2 a = gelu_pk((f32x2){v[0], v[1]}), b = gelu_pk((f32x2){v[2], v[3]}); return (f32x4){a.x, a.y, b.x, b.y}; }
__device__ __forceinline__ float silu1(float v) { return v * __builtin_amdgcn_rcpf(1.0f + __builtin_amdgcn_exp2f(-1.4426950408889634f * v)); }
__device__ __forceinline__ f32x4 silu4(f32x4 v) { return (f32x4){silu1(v[0]), silu1(v[1]), silu1(v[2]), silu1(v[3])}; }
__device__ __forceinline__ u32x2 pk4(f32x4 v) { u32x2 w; w.x = cvt_pk_bf16(v[0], v[1]); w.y = cvt_pk_bf16(v[2], v[3]); return w; }
__device__ __forceinline__ void rope4(f32x4& v0, f32x4& v1, const float* cs) {
    const f32x4 a = *(const f32x4*)cs, b = *(const f32x4*)(cs + 4);
    const f32x4 co = {a[0], a[2], b[0], b[2]}, si = {a[1], a[3], b[1], b[3]};
    const f32x4 o0 = v0 * co - v1 * si, o1 = v0 * si + v1 * co; v0 = o0; v1 = o1;
}

struct EpiIn0 {
    static constexpr bool PERM = false, AFTER_DRAIN = false;
    bf16_t* P0; const float* rope0; float* vvp;
    __device__ __forceinline__ void operator()(const f32x4 (&acc)[2][2][4][2], const Unit& u, int wr, int wc, int fr, int fq) const {
        const int row0 = u.pm * BM + wr * 64 + fr, pn = u.pn, colw = pn * BM + wc * 32 + 4 * fq;
        const bool latent = u.pm * BM < LROWS;
        if (pn <= 2) {
#pragma unroll
            for (int ai = 0; ai < 2; ++ai)
#pragma unroll
                for (int m = 0; m < 4; ++m) { const int row = row0 + ai * HALF + m * 16; const float* cs = rope0 + ((size_t)(row % SEQ) * 32 + (wc & 1) * 16 + 4 * fq) * 2;
                    bf16_t* rp = P0 + (size_t)row * N_IN0 + colw;
#pragma unroll
                    for (int bj = 0; bj < 2; ++bj) { f32x4 v0 = acc[ai][bj][m][0], v1 = acc[ai][bj][m][1];
                        if (!(pn == 2 && bj == 1)) { if (latent) rope4(v0, v1, cs); if (pn < 2) { v0 = v0 * QSCALE0; v1 = v1 * QSCALE0; } }
                        *(u32x2*)(rp + bj * HALF) = pk4(v0); *(u32x2*)(rp + bj * HALF + 16) = pk4(v1); }
                    asm volatile("" ::: "memory"); }
        } else if (pn <= 6) {
#pragma unroll
            for (int ai = 0; ai < 2; ++ai)
#pragma unroll
                for (int m = 0; m < 4; ++m) { const int row = row0 + ai * HALF + m * 16; bf16_t* rp = P0 + (size_t)row * N_IN0 + colw; float s = 0.f, q = 0.f;
#pragma unroll
                    for (int bj = 0; bj < 2; ++bj) { const f32x4 v0 = gelu4(acc[ai][bj][m][0]), v1 = gelu4(acc[ai][bj][m][1]);
                        s += (v0[0] + v0[1]) + (v0[2] + v0[3]) + (v1[0] + v1[1]) + (v1[2] + v1[3]);
                        q += (v0[0] * v0[0] + v0[1] * v0[1]) + (v0[2] * v0[2] + v0[3] * v0[3]) + (v1[0] * v1[0] + v1[1] * v1[1]) + (v1[2] * v1[2] + v1[3] * v1[3]);
                        *(u32x2*)(rp + bj * HALF) = pk4(v0); *(u32x2*)(rp + bj * HALF + 16) = pk4(v1); }
                    if (pn >= 5) { s += __shfl_xor(s, 16); s += __shfl_xor(s, 32); q += __shfl_xor(q, 16); q += __shfl_xor(q, 32);
                        if (fq == 0) *(f32x2*)(vvp + ((size_t)row * 8 + (pn - 5) * 4 + wc) * 2) = (f32x2){s, q}; } }
        } else {
#pragma unroll
            for (int ai = 0; ai < 2; ++ai)
#pragma unroll
                for (int m = 0; m < 4; ++m) { const int row = row0 + ai * HALF + m * 16; bf16_t* rp = P0 + (size_t)row * N_IN0 + colw;
#pragma unroll
                    for (int bj = 0; bj < 2; ++bj) { *(u32x2*)(rp + bj * HALF) = pk4(silu4(acc[ai][bj][m][0])); *(u32x2*)(rp + bj * HALF + 16) = pk4(silu4(acc[ai][bj][m][1])); } }
        }
    }
};
struct EpiOut {
    static constexpr bool PERM = false, AFTER_DRAIN = false;
    const float* res; float* dst; const float* resc; float* dstc; const float* mod;
    __device__ __forceinline__ void operator()(const f32x4 (&acc)[2][2][4][2], const Unit& u, int wr, int wc, int fr, int fq) const {
        const bool latent = u.pm * BM < LROWS; const int rbase = latent ? u.pm * BM : u.pm * BM - LROWS; const int mr = latent ? (u.pm * BM) / SEQ : 8;
        const float* rs = latent ? res : resc; float* ds = latent ? dst : dstc;
        const int row0 = rbase + wr * 64 + fr, col0 = u.pn * BM + wc * 32 + 4 * fq;
        f32x4 g[2][2];
#pragma unroll
        for (int bj = 0; bj < 2; ++bj)
#pragma unroll
            for (int n = 0; n < 2; ++n) g[bj][n] = *(const f32x4*)(mod + (size_t)mr * 3072 + 2048 + col0 + bj * HALF + n * 16);
#pragma unroll
        for (int ai = 0; ai < 2; ++ai)
#pragma unroll
            for (int m = 0; m < 4; ++m) { const size_t off = (size_t)(row0 + ai * HALF + m * 16) * DM + col0;
#pragma unroll
                for (int bj = 0; bj < 2; ++bj)
#pragma unroll
                    for (int n = 0; n < 2; ++n) { const f32x4 b = *(const f32x4*)(rs + off + bj * HALF + n * 16); *(f32x4*)(ds + off + bj * HALF + n * 16) = b + g[bj][n] * acc[ai][bj][m][n]; }
                if (m & 1) asm volatile("" ::: "memory"); }
    }
};
struct EpiIn1 {
    static constexpr bool PERM = false, AFTER_DRAIN = false;
    bf16_t *QA, *KVA, *KPE, *G1; float *qsp, *kvsp; const float* rope1;
    __device__ __forceinline__ void operator()(const f32x4 (&acc)[2][2][4][2], const Unit& u, int wr, int wc, int fr, int fq) const {
        const int row0 = u.pm * BM + wr * 64 + fr, pn = u.pn, cw = wc * 32 + 4 * fq; const bool latent = u.pm * BM < LROWS;
#pragma unroll
        for (int ai = 0; ai < 2; ++ai)
#pragma unroll
            for (int m = 0; m < 4; ++m) { const int row = row0 + ai * HALF + m * 16;
                if (pn == 0) { float q = 0.f; bf16_t* rp = QA + (size_t)row * 256 + cw;
#pragma unroll
                    for (int bj = 0; bj < 2; ++bj) { const f32x4 v0 = acc[ai][bj][m][0], v1 = acc[ai][bj][m][1];
                        q += (v0[0] * v0[0] + v0[1] * v0[1]) + (v0[2] * v0[2] + v0[3] * v0[3]) + (v1[0] * v1[0] + v1[1] * v1[1]) + (v1[2] * v1[2] + v1[3] * v1[3]);
                        *(u32x2*)(rp + bj * HALF) = pk4(v0); *(u32x2*)(rp + bj * HALF + 16) = pk4(v1); }
                    q += __shfl_xor(q, 16); q += __shfl_xor(q, 32); if (fq == 0) qsp[(size_t)row * 4 + wc] = q;
                } else if (pn == 1) { bf16_t* rp = KVA + (size_t)row * 256 + cw;
                    { const f32x4 v0 = acc[ai][0][m][0], v1 = acc[ai][0][m][1];
                      float q = (v0[0] * v0[0] + v0[1] * v0[1]) + (v0[2] * v0[2] + v0[3] * v0[3]) + (v1[0] * v1[0] + v1[1] * v1[1]) + (v1[2] * v1[2] + v1[3] * v1[3]);
                      *(u32x2*)(rp) = pk4(v0); *(u32x2*)(rp + 16) = pk4(v1);
                      q += __shfl_xor(q, 16); q += __shfl_xor(q, 32); if (fq == 0) kvsp[(size_t)row * 4 + wc] = q; }
                    *(u32x2*)(rp + HALF) = (u32x2){0u, 0u}; *(u32x2*)(rp + HALF + 16) = (u32x2){0u, 0u};
                    if (wc == 0) { f32x4 v0 = acc[ai][1][m][0], v1 = acc[ai][1][m][1];
                        if (latent) rope4(v0, v1, rope1 + ((size_t)(row % SEQ) * 16 + 4 * fq) * 2);
                        bf16_t* kp = KPE + (size_t)row * 32 + 4 * fq; *(u32x2*)(kp) = pk4(v0); *(u32x2*)(kp + 16) = pk4(v1); }
                } else { bf16_t* rp = G1 + (size_t)row * DM + (pn - 2) * BM + cw;
#pragma unroll
                    for (int bj = 0; bj < 2; ++bj) { *(u32x2*)(rp + bj * HALF) = pk4(silu4(acc[ai][bj][m][0])); *(u32x2*)(rp + bj * HALF + 16) = pk4(silu4(acc[ai][bj][m][1])); } }
                asm volatile("" ::: "memory");
            }
    }
};
struct EpiQb {
    static constexpr bool PERM = false, AFTER_DRAIN = false;
    bf16_t* Q1; const float* qsp; const float* rope1;
    __device__ __forceinline__ void operator()(const f32x4 (&acc)[2][2][4][2], const Unit& u, int wr, int wc, int fr, int fq) const {
        const int row0 = u.pm * BM + wr * 64 + fr, colw = u.pn * BM + wc * 32 + 4 * fq;
#pragma unroll
        for (int ai = 0; ai < 2; ++ai)
#pragma unroll
            for (int m = 0; m < 4; ++m) { const int row = row0 + ai * HALF + m * 16; const f32x4 sp = *(const f32x4*)(qsp + (size_t)row * 4);
                const float sc = QSCALE1 * __builtin_amdgcn_rsqf(((sp[0] + sp[1]) + (sp[2] + sp[3])) * (1.0f / 256) + NORM_EPS);
                bf16_t* rp = Q1 + (size_t)row * 1536 + colw;
#pragma unroll
                for (int bj = 0; bj < 2; ++bj) { f32x4 v0 = acc[ai][bj][m][0] * sc, v1 = acc[ai][bj][m][1] * sc; const int g32 = u.pn * 8 + bj * 4 + wc;
                    if (g32 % 3 == 2) rope4(v0, v1, rope1 + ((size_t)(row % SEQ) * 16 + 4 * fq) * 2);
                    *(u32x2*)(rp + bj * HALF) = pk4(v0); *(u32x2*)(rp + bj * HALF + 16) = pk4(v1); }
                asm volatile("" ::: "memory"); }
    }
};
struct EpiKvb {
    static constexpr bool PERM = false, AFTER_DRAIN = false;
    bf16_t *K1N, *V1; const float* kvsp;
    __device__ __forceinline__ void operator()(const f32x4 (&acc)[2][2][4][2], const Unit& u, int wr, int wc, int fr, int fq) const {
        const int row0 = u.pm * BM + wr * 64 + fr, colw = (u.pn & 3) * BM + wc * 32 + 4 * fq; bf16_t* dst = u.pn < 4 ? K1N : V1;
#pragma unroll
        for (int ai = 0; ai < 2; ++ai)
#pragma unroll
            for (int m = 0; m < 4; ++m) { const int row = row0 + ai * HALF + m * 16; const f32x4 sp = *(const f32x4*)(kvsp + (size_t)row * 4);
                const float sc = __builtin_amdgcn_rsqf(((sp[0] + sp[1]) + (sp[2] + sp[3])) * (1.0f / 128) + NORM_EPS);
                bf16_t* rp = dst + (size_t)row * DM + colw;
#pragma unroll
                for (int bj = 0; bj < 2; ++bj) { *(u32x2*)(rp + bj * HALF) = pk4(acc[ai][bj][m][0] * sc); *(u32x2*)(rp + bj * HALF + 16) = pk4(acc[ai][bj][m][1] * sc); }
                asm volatile("" ::: "memory"); }
    }
};
}
namespace att {
using bf16x8 = __attribute__((ext_vector_type(8))) short;
using s16x4 = __attribute__((ext_vector_type(4))) short;
using f32x16 = __attribute__((ext_vector_type(16))) float;
using u32x4 = __attribute__((ext_vector_type(4))) unsigned;
typedef short v4i16_t __attribute__((ext_vector_type(4)));
typedef float f32x2_t __attribute__((ext_vector_type(2))); typedef __bf16 bf16x2_t __attribute__((ext_vector_type(2)));
constexpr int NW = 8, QBLK = 32, QB = 256, KVBLK = 64, NSLOT = 3;
constexpr int KSLOT = 12288, VSLOT = 8192;
constexpr int LDS_K = 0, LDS_V = NSLOT * KSLOT, LDS_WS = LDS_V + NSLOT * VSLOT, LDS_OST = LDS_WS + NW * 64 * 4, LDS_BYTES = LDS_OST + NW * 4096;
constexpr float THR = 6.0f;
__device__ __forceinline__ int crow(int r, int hi) { return (r & 3) + 8 * (r >> 2) + 4 * hi; }
__device__ __forceinline__ void glds16(const void* gsrc, unsigned lds_dst) { unsigned keep;
    asm volatile("s_mov_b32 %0, m0\n\ts_mov_b32 m0, %2\n\ts_nop 0\n\tglobal_load_lds_dwordx4 %1, off\n\ts_mov_b32 m0, %0" : "=&s"(keep) : "v"(gsrc), "s"(lds_dst) : "memory"); }
__device__ __forceinline__ unsigned cvtpk(float lo, float hi) { f32x2_t v = {lo, hi}; bf16x2_t b = __builtin_convertvector(v, bf16x2_t); return __builtin_bit_cast(unsigned, b); }
#define ATT_WAIT_BAR(N) asm volatile("s_waitcnt vmcnt(" #N ") lgkmcnt(0)\n\ts_barrier" ::: "memory")
#define ATT_SBAR() __builtin_amdgcn_sched_barrier(0)

struct Desc {
    const bf16_t* Q; int qpitch;
    const bf16_t* K; int kpitch;
    const bf16_t* K2; int k2pitch;
    const bf16_t* V; int vpitch;
    const bf16_t* G; int gpitch;
    bf16_t* O; int opitch;
    long qrow0;
    long lat_row0; int ntl;
    long ctx_row0; int ntc;
    int band_q0, band_k0;
    float sink; int has_sink;
};

template <int ND0, bool WINDOWED>
__device__ __forceinline__ void unit(const Desc& D, char* shm) {
    constexpr int NCH = 2 * ND0;
    int tid_ = threadIdx.x; asm volatile("" : "+v"(tid_));
    const int tid = tid_, lane = tid & 63, r32 = lane & 31, hi = lane >> 5; const int wid = __builtin_amdgcn_readfirstlane(tid >> 6);
    const unsigned lds0 = (unsigned)(uintptr_t)shm;
    float* wsf = (float*)(shm + LDS_WS) + wid * 64;
    const int NT = D.ntl + D.ntc;
    const int ch2 = 8 + (wid & 3);
    const unsigned kdst = lds0 + LDS_K + wid * 1024, kdst2 = lds0 + LDS_K + ch2 * 1024, vdst = lds0 + LDS_V + wid * 1024;
    const int vr = 16 * (wid & 3) + (lane >> 2), vc = (wid >> 2) * 32 + (lane & 3) * 8;
#define ATT_KROW0(t) ((t) < D.ntl ? D.lat_row0 + (long)(t) * KVBLK : D.ctx_row0 + (long)((t) - D.ntl) * KVBLK)
#define ATT_DMA(t, slot) do { const long kr0_ = ATT_KROW0(t); \
        glds16(D.K + (kr0_ + lane) * D.kpitch + wid * 8, (unsigned)__builtin_amdgcn_readfirstlane(kdst + (slot) * KSLOT)); \
        if (NCH > 8 && wid < 4) glds16(D.K2 + (kr0_ + lane) * D.k2pitch + (ch2 - 8) * 8, (unsigned)__builtin_amdgcn_readfirstlane(kdst2 + (slot) * KSLOT)); \
        glds16(D.V + (kr0_ + vr) * D.vpitch + vc, (unsigned)__builtin_amdgcn_readfirstlane(vdst + (slot) * VSLOT)); } while (0)
#define ATT_WAIT_TILE(ahead) do { if (NCH > 8 && wid < 4) { if ((ahead) == 2) ATT_WAIT_BAR(6); else if ((ahead) == 1) ATT_WAIT_BAR(3); else ATT_WAIT_BAR(0); } \
        else { if ((ahead) == 2) ATT_WAIT_BAR(4); else if ((ahead) == 1) ATT_WAIT_BAR(2); else ATT_WAIT_BAR(0); } } while (0)
    ATT_DMA(0, 0);
    if (NT > 1) ATT_DMA(1, 1);
    const bf16_t* Qw = D.Q + (D.qrow0 + wid * QBLK + r32) * D.qpitch;
    bf16x8 qr[ND0];
#pragma unroll
    for (int d0 = 0; d0 < ND0; ++d0) qr[d0] = *reinterpret_cast<const bf16x8*>(Qw + d0 * 16 + hi * 8);
    float mhat = -1e4f, l_reg = 0.f; f32x16 o[2];
    o[0] = f32x16{}; o[1] = f32x16{};
    const int qidx = D.band_q0 + wid * QBLK;
    const int vb0 = (int)(lds0 + LDS_V) + ((lane >> 4) & 1) * 32 + (lane & 3) * 8 + (4 * hi + ((lane & 15) >> 2)) * 64;
    int slot = 0;
    for (int t = 0; t < NT; ++t) {
        if (t + 1 < NT) { ATT_WAIT_TILE(1); } else { ATT_WAIT_TILE(0); }
        if (t + 2 < NT) { const int s2 = slot + 2 >= NSLOT ? slot + 2 - NSLOT : slot + 2; ATT_DMA(t + 2, s2); }
        bool skip = false, domask = false; int jt = 0;
        if (WINDOWED && t < D.ntl) { jt = D.band_k0 + t * KVBLK;
            skip = (jt - (qidx + 31) > 128) || (qidx - (jt + 63) > 128);
            domask = !((jt + 63 - qidx <= 128) && (qidx + 31 - jt <= 128)); }
        if (!skip) {
            const char* kb = shm + LDS_K + slot * KSLOT + hi * 1024 + r32 * 16;
            f32x16 p0 = f32x16{}, p1 = f32x16{};
#pragma unroll
            for (int d0 = 0; d0 < ND0; ++d0) {
                const bf16x8 b0 = *reinterpret_cast<const bf16x8*>(kb + d0 * 2048);
                const bf16x8 b1 = *reinterpret_cast<const bf16x8*>(kb + d0 * 2048 + 512);
                p0 = __builtin_amdgcn_mfma_f32_32x32x16_bf16(b0, qr[d0], p0, 0, 0, 0);
                p1 = __builtin_amdgcn_mfma_f32_32x32x16_bf16(b1, qr[d0], p1, 0, 0, 0);
            }
            if (WINDOWED && domask) { const int qi = qidx + r32;
#pragma unroll
                for (int r = 0; r < 16; ++r) { const int j = jt + crow(r, hi); const int d0_ = j - qi, d1_ = d0_ + 32;
                    if (d0_ > 128 || d0_ < -128) p0[r] = -1e30f; if (d1_ > 128 || d1_ < -128) p1[r] = -1e30f; } }
            float rm = fmaxf(p0[0], p1[0]);
#pragma unroll
            for (int r = 1; r < 16; ++r) rm = fmaxf(rm, fmaxf(p0[r], p1[r]));
            rm -= mhat;
            { auto rr = __builtin_amdgcn_permlane32_swap(__float_as_uint(rm), __float_as_uint(rm), false, false); rm = fmaxf(__uint_as_float(rr[0]), __uint_as_float(rr[1])); }
            if (__any(rm > THR)) {
                const float dl = fmaxf(rm, 0.f); mhat += dl; const float f = __builtin_amdgcn_exp2f(-dl); l_reg *= f;
                if (hi == 0) wsf[r32] = f;
                asm volatile("s_waitcnt lgkmcnt(0)" ::: "memory");
#pragma unroll
                for (int r = 0; r < 16; ++r) { const float fr_ = wsf[crow(r, hi)]; o[0][r] *= fr_; o[1][r] *= fr_; }
            }
            float sacc = 0.f;
#pragma unroll
            for (int r = 0; r < 16; ++r) { p0[r] = __builtin_amdgcn_exp2f(p0[r] - mhat); p1[r] = __builtin_amdgcn_exp2f(p1[r] - mhat); sacc += p0[r] + p1[r]; }
            l_reg += sacc;
            u32x4 pw0 = {cvtpk(p0[0], p0[1]), cvtpk(p0[2], p0[3]), cvtpk(p0[4], p0[5]), cvtpk(p0[6], p0[7])};
            u32x4 pw1 = {cvtpk(p0[8], p0[9]), cvtpk(p0[10], p0[11]), cvtpk(p0[12], p0[13]), cvtpk(p0[14], p0[15])};
            u32x4 pw2 = {cvtpk(p1[0], p1[1]), cvtpk(p1[2], p1[3]), cvtpk(p1[4], p1[5]), cvtpk(p1[6], p1[7])};
            u32x4 pw3 = {cvtpk(p1[8], p1[9]), cvtpk(p1[10], p1[11]), cvtpk(p1[12], p1[13]), cvtpk(p1[14], p1[15])};
            const bf16x8 pa[4] = {__builtin_bit_cast(bf16x8, pw0), __builtin_bit_cast(bf16x8, pw1), __builtin_bit_cast(bf16x8, pw2), __builtin_bit_cast(bf16x8, pw3)};
            const int vb = vb0 + slot * VSLOT;
#pragma unroll
            for (int d0 = 0; d0 < 2; ++d0) { s16x4 lo[4], hh[4];
#pragma unroll
                for (int ks = 0; ks < 4; ++ks) {
                    asm volatile("ds_read_b64_tr_b16 %0,%1 offset:%c2" : "=&v"(lo[ks]) : "v"(vb), "i"(d0 * 4096 + ks * 1024) : "memory");
                    asm volatile("ds_read_b64_tr_b16 %0,%1 offset:%c2" : "=&v"(hh[ks]) : "v"(vb), "i"(d0 * 4096 + ks * 1024 + 512) : "memory"); }
                asm volatile("s_waitcnt lgkmcnt(0)" ::: "memory"); ATT_SBAR();
#pragma unroll
                for (int ks = 0; ks < 4; ++ks) { const bf16x8 vf = {lo[ks][0], lo[ks][1], lo[ks][2], lo[ks][3], hh[ks][0], hh[ks][1], hh[ks][2], hh[ks][3]};
                    o[d0] = __builtin_amdgcn_mfma_f32_32x32x16_bf16(pa[ks], vf, o[d0], 0, 0, 0); }
            }
        }
        slot = slot + 1 >= NSLOT ? 0 : slot + 1;
    }
    { auto rr = __builtin_amdgcn_permlane32_swap(__float_as_uint(l_reg), __float_as_uint(l_reg), false, false); l_reg = __uint_as_float(rr[0]) + __uint_as_float(rr[1]); }
    if (D.has_sink) l_reg += __builtin_amdgcn_exp2f(D.sink - mhat);
    if (hi == 0) wsf[32 + r32] = l_reg;
    asm volatile("s_waitcnt lgkmcnt(0)" ::: "memory");
    float rli[16];
#pragma unroll
    for (int r = 0; r < 16; ++r) rli[r] = __builtin_amdgcn_rcpf(wsf[32 + crow(r, hi)]);
    { __hip_bfloat16* stg = (__hip_bfloat16*)(shm + LDS_OST) + wid * 2048;
#pragma unroll
      for (int r = 0; r < 16; ++r) { const int orow = crow(r, hi);
#pragma unroll
          for (int d0 = 0; d0 < 2; ++d0) stg[orow * 64 + d0 * 32 + r32] = __float2bfloat16(o[d0][r] * rli[r]); }
      asm volatile("s_waitcnt lgkmcnt(0)" ::: "memory");
#pragma unroll
      for (int i = 0; i < 4; ++i) { const int row = i * 8 + (lane >> 3), c8 = (lane & 7) * 8; const long grow = D.qrow0 + wid * QBLK + row;
          const u32x4 ov = *(const u32x4*)(stg + row * 64 + c8); const u32x4 gv = *(const u32x4*)(D.G + grow * D.gpitch + c8); u32x4 w;
#pragma unroll
          for (int k = 0; k < 4; ++k) { const float a0 = __uint_as_float(ov[k] << 16) * __uint_as_float(gv[k] << 16), a1 = __uint_as_float(ov[k] & 0xffff0000u) * __uint_as_float(gv[k] & 0xffff0000u); w[k] = cvtpk(a0, a1); }
          *(u32x4*)(D.O + grow * D.opitch + c8) = w; } }
    asm volatile("s_waitcnt vmcnt(0) lgkmcnt(0)\n\ts_barrier" ::: "memory");
#undef ATT_KROW0
#undef ATT_DMA
#undef ATT_WAIT_TILE
}
}
namespace thin {
#define TH_LAS __attribute__((address_space(3)))
typedef float f32x4 __attribute__((ext_vector_type(4)));
typedef float f32x2 __attribute__((ext_vector_type(2)));
typedef float f32x16 __attribute__((ext_vector_type(16)));
typedef unsigned u32x4 __attribute__((ext_vector_type(4)));
typedef unsigned u32x2 __attribute__((ext_vector_type(2)));
typedef short bf16x8 __attribute__((ext_vector_type(8)));
__device__ __forceinline__ unsigned pk2(float lo, float hi) { return (unsigned)f2bf(lo) | ((unsigned)f2bf(hi) << 16); }
__device__ __forceinline__ float wave_sum(float v) {
#pragma unroll
    for (int o = 1; o < 64; o <<= 1) v += __shfl_xor(v, o);
    return v;
}
struct MapId { __device__ __forceinline__ int operator()(int n) const { return n; } };
struct MapIn1 { __device__ __forceinline__ int operator()(int n) const { return n < 384 ? n : (n < 416 ? 384 + pe_orig(n - 384) : (n < 512 ? -1 : n - 96)); } };
struct MapQb { __device__ __forceinline__ int operator()(int n) const { const int h = n / 96, w = n % 96; return h * 96 + (w < 64 ? w : 64 + pe_orig(w - 64)); } };
struct MapKvb { __device__ __forceinline__ int operator()(int n) const { const int nn = n & 1023; return (nn >> 6) * 128 + (nn & 63) + (n >= 1024 ? 64 : 0); } };
template <class MAP>
__device__ __forceinline__ void wcopy_item(const float* W, int Ksrc, int ldw, bf16_t* WT, int ldt, const float* scale, TH_LAS float* scr, int item, int nblk, int lane, MAP map) {
    const int kb = item / nblk, nb = item % nblk, k0 = 64 * kb, n0 = 32 * nb;
    const int sc = map(n0 + (lane & 31));
#pragma unroll 8
    for (int i = 0; i < 32; ++i) { const int kk = 2 * i + (lane >> 5); float v = 0.f;
        if (sc >= 0 && k0 + kk < Ksrc) { v = W[(size_t)(k0 + kk) * ldw + sc]; if (scale) v *= scale[k0 + kk]; }
        scr[kk * 33 + (lane & 31)] = v; }
    asm volatile("s_waitcnt lgkmcnt(0)" ::: "memory");
    const int c = lane & 7;
#pragma unroll
    for (int j = 0; j < 4; ++j) { const int n = (lane >> 3) + 8 * j; const TH_LAS float* s = scr + (8 * c) * 33 + n;
        u32x4 o; o.x = pk2(s[0 * 33], s[1 * 33]); o.y = pk2(s[2 * 33], s[3 * 33]); o.z = pk2(s[4 * 33], s[5 * 33]); o.w = pk2(s[6 * 33], s[7 * 33]);
        *(u32x4*)(WT + (size_t)(n0 + n) * ldt + k0 + 8 * c) = o; }
    asm volatile("s_waitcnt lgkmcnt(0)" ::: "memory");
}
constexpr int WI_IN0 = 16 * 88, WI_OUT0 = 16 * 32, WI_IN1 = 16 * 48, WI_QB = 4 * 48, WI_KVB = 4 * 64, WI_OUT1 = 16 * 32, WI_WS = 64  ;
constexpr int WI_ROPE = (SEQ * 48 + 63) / 64, WI_ADA = 2 * 12 * 32;
constexpr int WI_TOTAL = WI_IN0 + WI_OUT0 + WI_IN1 + WI_QB + WI_KVB + WI_OUT1 + WI_WS + WI_ROPE + WI_ADA;
__device__ __forceinline__ void stage0_item(const Params& p, int it, TH_LAS float* scr, int lane) {
    if (it < WI_ADA) {
        const int l = it / (12 * 32), nb = (it / 32) % 12, ks = it % 32, n = nb * 256 + lane * 4;
        f32x4 acc[9];
#pragma unroll
        for (int r = 0; r < 9; ++r) acc[r] = (f32x4){0.f, 0.f, 0.f, 0.f};
        const float* w = p.w_ada + (size_t)l * DM * 3072 + n;
#pragma unroll 4
        for (int k = ks * 32; k < ks * 32 + 32; ++k) { const f32x4 wv = *(const f32x4*)(w + (size_t)k * 3072);
#pragma unroll
            for (int r = 0; r < 9; ++r) { const float cv = r < 8 ? p.c[r * DM + k] : p.c_ctx[k]; acc[r] += wv * (cv * __builtin_amdgcn_rcpf(1.0f + __expf(-cv))); } }
        if (ks == 0) { const f32x4 bb = *(const f32x4*)(p.b_ada + l * 3072 + n);
#pragma unroll
            for (int r = 0; r < 9; ++r) acc[r] += bb; }
        float* md = WSP(float, WS_MOD) + (size_t)l * 9 * 3072 + n;
#pragma unroll
        for (int r = 0; r < 9; ++r)
#pragma unroll
            for (int i = 0; i < 4; ++i) atomicAdd(md + (size_t)r * 3072 + i, acc[r][i]);
        return; } it -= WI_ADA;
    if (it < WI_IN0) { wcopy_item(p.w_in0, DM, N_IN0, WSP(bf16_t, WS_WIN0), DM, nullptr, scr, it, 88, lane, MapId()); return; } it -= WI_IN0;
    if (it < WI_OUT0) { wcopy_item(p.w_out0, DM, DM, WSP(bf16_t, WS_WOUT0), DM, nullptr, scr, it, 32, lane, MapId()); return; } it -= WI_OUT0;
    if (it < WI_IN1) { wcopy_item(p.w_in1, DM, 1440, WSP(bf16_t, WS_WIN1), DM, nullptr, scr, it, 48, lane, MapIn1()); return; } it -= WI_IN1;
    if (it < WI_QB) { wcopy_item(p.w_qb, 256, 1536, WSP(bf16_t, WS_WQB), 256, p.q_norm, scr, it, 48, lane, MapQb()); return; } it -= WI_QB;
    if (it < WI_KVB) { wcopy_item(p.w_kvb, 128, 2048, WSP(bf16_t, WS_WKVB), 256, p.kv_norm, scr, it, 64, lane, MapKvb()); return; } it -= WI_KVB;
    if (it < WI_OUT1) { wcopy_item(p.w_out1, DM, DM, WSP(bf16_t, WS_WOUT1), DM, nullptr, scr, it, 32, lane, MapId()); return; } it -= WI_OUT1;
    if (it < WI_WS) { const size_t base = (size_t)it * 2048 + lane * 4;
#pragma unroll
        for (int j = 0; j < 8; ++j) { const f32x4 v = *(const f32x4*)(p.gm_ws + base + j * 256); *(u32x2*)(WSP(bf16_t, WS_WS) + base + j * 256) = (u32x2){pk2(v[0], v[1]), pk2(v[2], v[3])}; }
        return; } it -= WI_WS;
    { const long e = (long)it * 64 + lane; if (e < ROPE_ITEMS) nk_rope(p, e); }
}
__device__ __forceinline__ void modnorm_row(const Params& p, long r, int layer, int lane) {
    const float* src; int mr;
    if (r < LROWS) { src = (layer == 0 ? p.x : p.out) + (size_t)r * DM; mr = (int)(r / SEQ); }
    else { src = (layer == 0 ? p.ctx : WSP(float, WS_X1C)) + (size_t)(r - LROWS) * DM; mr = 8; }
    const f32x4* xr = (const f32x4*)src + lane; f32x4 v[4]; float s = 0.f;
#pragma unroll
    for (int j = 0; j < 4; ++j) { v[j] = xr[64 * j]; s += (v[j][0] * v[j][0] + v[j][1] * v[j][1]) + (v[j][2] * v[j][2] + v[j][3] * v[j][3]); }
    const float rstd = 1.0f / sqrtf(wave_sum(s) * (1.0f / DM) + NORM_EPS);
    const f32x4* md = (const f32x4*)(WSP(float, WS_MOD) + ((size_t)layer * 9 + mr) * 3072) + lane; const f32x4* g = (const f32x4*)(p.norm_g + layer * DM) + lane;
    u32x2* o = (u32x2*)(WSP(bf16_t, WS_H) + (size_t)r * DM) + lane;
#pragma unroll
    for (int j = 0; j < 4; ++j) { const f32x4 sh = md[64 * j], sc = md[256 + 64 * j], gg = g[64 * j]; const f32x4 y = v[j] * rstd * gg * (sc + 1.0f) + sh; o[64 * j] = (u32x2){pk2(y[0], y[1]), pk2(y[2], y[3])}; }
}
__device__ __forceinline__ void final_row(const Params& p, long r, int lane) {
    f32x4* xr = (f32x4*)(p.out + (size_t)r * DM) + lane; f32x4 v[4]; float s = 0.f;
#pragma unroll
    for (int j = 0; j < 4; ++j) { v[j] = xr[64 * j]; s += (v[j][0] * v[j][0] + v[j][1] * v[j][1]) + (v[j][2] * v[j][2] + v[j][3] * v[j][3]); }
    const float rstd = 1.0f / sqrtf(wave_sum(s) * (1.0f / DM) + NORM_EPS); const f32x4* g = (const f32x4*)p.final_g + lane;
#pragma unroll
    for (int j = 0; j < 4; ++j) xr[64 * j] = v[j] * rstd * g[64 * j];
}
constexpr int GM_PITCH = 136;
constexpr int GM_LDS = 64 * GM_PITCH * 2;
__device__ __forceinline__ void gmlp_unit(const Params& p, long r0, int g, char* shm) {
    int tid_ = threadIdx.x; asm volatile("" : "+v"(tid_));
    const int tid = tid_, lane = tid & 63, r32 = lane & 31, hi = lane >> 5; const int wid = __builtin_amdgcn_readfirstlane(tid >> 6);
    const bf16_t* P0 = WSP(bf16_t, WS_P0); bf16_t* vnT = (bf16_t*)shm;
#pragma unroll
    for (int rep = 0; rep < 2; ++rep) { const int item = tid + rep * 512, q = item >> 3, c8 = item & 7;
        const f32x4* pt = (const f32x4*)(WSP(float, WS_VVP) + (size_t)(r0 + q) * 16); const f32x4 a = pt[0], b = pt[1], c = pt[2], d = pt[3];
        const float sm = (a[0] + a[2]) + (b[0] + b[2]) + (c[0] + c[2]) + (d[0] + d[2]), sq = (a[1] + a[3]) + (b[1] + b[3]) + (c[1] + c[3]) + (d[1] + d[3]);
        const float mean = sm * (1.0f / 512), rstd = __builtin_amdgcn_rsqf(sq * (1.0f / 512) - mean * mean + NORM_EPS);
        const u32x4 raw = *(const u32x4*)(P0 + (size_t)(r0 + q) * N_IN0 + C_VV + 64 * g + 8 * c8);
        const f32x4 g0 = *(const f32x4*)(p.gm_ln_g + 64 * g + 8 * c8), g1 = *(const f32x4*)(p.gm_ln_g + 64 * g + 8 * c8 + 4);
        const f32x4 b0 = *(const f32x4*)(p.gm_ln_b + 64 * g + 8 * c8), b1 = *(const f32x4*)(p.gm_ln_b + 64 * g + 8 * c8 + 4);
#pragma unroll
        for (int k = 0; k < 4; ++k) { const float x0 = __uint_as_float(raw[k] << 16), x1 = __uint_as_float(raw[k] & 0xffff0000u);
            const float gg0 = k < 2 ? g0[2 * k] : g1[2 * k - 4], gg1 = k < 2 ? g0[2 * k + 1] : g1[2 * k - 3], bb0 = k < 2 ? b0[2 * k] : b1[2 * k - 4], bb1 = k < 2 ? b0[2 * k + 1] : b1[2 * k - 3];
            vnT[(8 * c8 + 2 * k) * GM_PITCH + q] = f2bf((x0 - mean) * rstd * gg0 + bb0); vnT[(8 * c8 + 2 * k + 1) * GM_PITCH + q] = f2bf((x1 - mean) * rstd * gg1 + bb1); } }
    __syncthreads();
    const int pb = wid & 3, cbk = wid >> 2;
    const bf16_t* wr_ = WSP(bf16_t, WS_WS) + ((size_t)g * 128 + 32 * pb + r32) * 128 + 8 * hi; const bf16_t* ar_ = vnT + (32 * cbk + r32) * GM_PITCH + 8 * hi;
    f32x16 acc = f32x16{};
#pragma unroll
    for (int ks = 0; ks < 8; ++ks) { const bf16x8 af = *(const bf16x8*)(ar_ + 16 * ks), bf = *(const bf16x8*)(wr_ + 16 * ks); acc = __builtin_amdgcn_mfma_f32_32x32x16_bf16(af, bf, acc, 0, 0, 0); }
    const long row = r0 + 32 * pb + r32; const float bs = p.gm_bs[g * 128 + 32 * pb + r32];
    const bf16_t* prow = P0 + (size_t)row * N_IN0; bf16_t* orow = WSP(bf16_t, WS_MIX) + (size_t)row * DM + 512;
#pragma unroll
    for (int g4 = 0; g4 < 4; ++g4) { const int cc = 64 * g + 32 * cbk + 8 * g4 + 4 * hi;
        const u32x2 uu = *(const u32x2*)(prow + C_U + cc), gt = *(const u32x2*)(prow + C_G + 512 + cc); u32x2 w;
#pragma unroll
        for (int k = 0; k < 2; ++k) { const float u0 = __uint_as_float(uu[k] << 16), u1 = __uint_as_float(uu[k] & 0xffff0000u), t0 = __uint_as_float(gt[k] << 16), t1 = __uint_as_float(gt[k] & 0xffff0000u);
            w[k] = pk2(u0 * (acc[4 * g4 + 2 * k] + bs) * t0, u1 * (acc[4 * g4 + 2 * k + 1] + bs) * t1); }
        *(u32x2*)(orow + cc) = w; }
    __syncthreads();
}
}
namespace cg = cooperative_groups;
constexpr int NTHREADS = 512, NWAVES = 8;
constexpr int LDS_BYTES = 147456;
static_assert(att::LDS_BYTES <= 131072 && thin::GM_LDS <= 131072 && NWAVES * 64 * 33 * 4 <= 131072, "LDS map");
#ifndef GSEL_IN0
#define GSEL_IN0 1
#endif
#ifndef GSEL_OUT0
#define GSEL_OUT0 1
#endif
#ifndef GSEL_IN1
#define GSEL_IN1 1
#endif
#ifndef GSEL_QB
#define GSEL_QB 1
#endif
#ifndef GSEL_KVB
#define GSEL_KVB 1
#endif
#ifndef GSEL_OUT1
#define GSEL_OUT1 1
#endif
#ifndef OPT_S0
#define OPT_S0 1
#endif
#ifndef OPT_NORM
#define OPT_NORM 1
#endif
#ifndef OPT_GEMM
#define OPT_GEMM 1
#endif
#ifndef OPT_ATT0
#define OPT_ATT0 1
#endif
#ifndef OPT_GMLP
#define OPT_GMLP 1
#endif
#ifndef OPT_ATT1
#define OPT_ATT1 1
#endif

template <int S> __device__ __forceinline__ void naive_stage(const Params& p) {
    const long n = stage_items(S);
    for (long it = (long)blockIdx.x * NTHREADS + threadIdx.x; it < n; it += (long)gridDim.x * NTHREADS) stage_item(p, S, it);
}
#define GRID_SYNC() grid.sync()

__global__ void __launch_bounds__(NTHREADS, 2) k_fwd(Params p) {
    extern __shared__ __attribute__((aligned(16))) unsigned char lds[];
    cg::grid_group grid = cg::this_grid();
    const int tid = threadIdx.x, lane = tid & 63, wid = __builtin_amdgcn_readfirstlane(tid >> 6);
    const int G = gridDim.x, bid = blockIdx.x, vcu = (G % 8 == 0) ? (bid % 8) * (G / 8) + bid / 8 : bid;
    PG8_LAS unsigned char* glds = (PG8_LAS unsigned char*)lds;
    bf16_t* const H = WSP(bf16_t, WS_H); bf16_t* const P0 = WSP(bf16_t, WS_P0); bf16_t* const MIX = WSP(bf16_t, WS_MIX);
    float* const MOD = WSP(float, WS_MOD);

#if OPT_S0
    { TH_LAS float* scr = (TH_LAS float*)lds + wid * (64 * 33);
      for (int it = vcu * NWAVES + wid; it < thin::WI_TOTAL; it += G * NWAVES) thin::stage0_item(p, it, scr, lane); }
#else
    naive_stage<0>(p); naive_stage<1>(p); naive_stage<2>(p);
#endif
    GRID_SYNC();
#if OPT_NORM
    for (long r = (long)bid * NWAVES + wid; r < ROWS; r += (long)G * NWAVES) thin::modnorm_row(p, r, 0, lane);
#else
    naive_stage<3>(p);
#endif
    GRID_SYNC();
#if OPT_GEMM
#if GSEL_IN0
    { pg8::Gemm g{H, WSP(bf16_t, WS_WIN0), ROWS, N_IN0, DM}; pg8::StaticOrder S; S.init(ROWS, N_IN0, G, bid);
      pg8::EpiIn0 E{P0, WSP(float, WS_ROPE0), WSP(float, WS_VVP)};
      pg8::gemm_phase<pg8::EpiIn0, pg8::StaticOrder, true, true>(glds, g, S, E); }
#endif
#else
    naive_stage<4>(p); GRID_SYNC(); naive_stage<5>(p);
#endif
    GRID_SYNC();
#if OPT_ATT0
    for (int u = vcu; u < NB * 64 + NB * 8; u += G) {
        att::Desc D; int b, h;
        if (u < NB * 64) { b = u >> 6; const int rem = u & 63, hk = rem >> 5, qb = (rem >> 2) & 7; h = hk * 4 + (rem & 3);
            const int q0 = qb * 256; int tl0 = q0 / 64 - 2; if (tl0 < 0) tl0 = 0; int tl1 = q0 / 64 + 5; if (tl1 > SEQ / 64 - 1) tl1 = SEQ / 64 - 1;
            D.qrow0 = (long)b * SEQ + q0; D.lat_row0 = (long)b * SEQ + 64 * tl0; D.ntl = tl1 - tl0 + 1; D.band_q0 = q0; D.band_k0 = 64 * tl0; }
        else { const int cu = u - NB * 64; b = cu >> 3; h = cu & 7; D.qrow0 = LROWS + (long)b * CTX; D.lat_row0 = 0; D.ntl = 0; D.band_q0 = 0; D.band_k0 = 0; }
        const int hk = h >> 2;
        D.Q = P0 + C_Q + 64 * h; D.qpitch = N_IN0; D.K = P0 + C_K + 64 * hk; D.kpitch = N_IN0; D.K2 = nullptr; D.k2pitch = 0; D.V = P0 + C_V + 64 * hk; D.vpitch = N_IN0;
        D.G = P0 + C_G + 64 * h; D.gpitch = N_IN0; D.O = MIX + 64 * h; D.opitch = DM; D.ctx_row0 = LROWS + (long)b * CTX; D.ntc = CTX / 64; D.sink = p.sink0[h] * LOG2E; D.has_sink = 1;
        if (u < NB * 64) att::unit<4, true>(D, (char*)lds); else att::unit<4, false>(D, (char*)lds);
    }
#else
    naive_stage<6>(p);
#endif
#if OPT_GMLP
    __syncthreads();
    for (int u = vcu; u < (ROWS / 128) * 8; u += G) thin::gmlp_unit(p, (long)(u >> 3) * 128, u & 7, (char*)lds);
#else
    naive_stage<7>(p);
#endif
    GRID_SYNC();
#if OPT_GEMM
#if GSEL_OUT0
    { pg8::Gemm g{MIX, WSP(bf16_t, WS_WOUT0), ROWS, DM, DM}; pg8::StaticOrder S; S.init(ROWS, DM, G, bid);
      pg8::EpiOut E{p.x, p.out, p.ctx, WSP(float, WS_X1C), MOD};
      pg8::gemm_phase<pg8::EpiOut, pg8::StaticOrder, true, true>(glds, g, S, E); }
#endif
#else
    naive_stage<8>(p);
#endif
    GRID_SYNC();
#if OPT_NORM
    for (long r = (long)bid * NWAVES + wid; r < ROWS; r += (long)G * NWAVES) thin::modnorm_row(p, r, 1, lane);
#else
    naive_stage<9>(p);
#endif
    GRID_SYNC();
#if OPT_GEMM
#if GSEL_IN1
    { pg8::Gemm g{H, WSP(bf16_t, WS_WIN1), ROWS, N_IN1, DM}; pg8::ExtOrder S; S.init2(LROWS, N_IN1, G, bid, CROWS / 256, LROWS / 256, 1);
      pg8::EpiIn1 E{WSP(bf16_t, WS_QA), WSP(bf16_t, WS_KVA), WSP(bf16_t, WS_KPE), WSP(bf16_t, WS_G1), WSP(float, WS_QSP), WSP(float, WS_KVSP), WSP(float, WS_ROPE1)};
      pg8::gemm_phase<pg8::EpiIn1, pg8::ExtOrder, true, true>(glds, g, S, E); }
#endif
#else
    naive_stage<10>(p); GRID_SYNC(); naive_stage<11>(p);
#endif
    GRID_SYNC();
#if OPT_GEMM
#if GSEL_QB
    { pg8::Gemm g{WSP(bf16_t, WS_QA), WSP(bf16_t, WS_WQB), LROWS, 1536, 256}; pg8::StaticOrder S; S.init(LROWS, 1536, G, bid);
      pg8::EpiQb E{WSP(bf16_t, WS_Q1), WSP(float, WS_QSP), WSP(float, WS_ROPE1)};
      pg8::gemm_phase<pg8::EpiQb, pg8::StaticOrder, true, true>(glds, g, S, E); }
#endif
#if GSEL_KVB
    { pg8::Gemm g{WSP(bf16_t, WS_KVA), WSP(bf16_t, WS_WKVB), ROWS, 2048, 256}; pg8::StaticOrder S; S.init(ROWS, 2048, G, (bid + G / 2) % G);
      pg8::EpiKvb E{WSP(bf16_t, WS_K1N), WSP(bf16_t, WS_V1), WSP(float, WS_KVSP)};
      pg8::gemm_phase<pg8::EpiKvb, pg8::StaticOrder, true, true>(glds, g, S, E); }
#endif
#else
    naive_stage<12>(p); naive_stage<13>(p);
#endif
    GRID_SYNC();
#if OPT_ATT1
    for (int u = vcu; u < NB * 16 * (SEQ / 256); u += G) {
        const int qb = u % (SEQ / 256), h = (u / (SEQ / 256)) & 15, b = u / (16 * (SEQ / 256)); att::Desc D;
        D.Q = WSP(bf16_t, WS_Q1) + 96 * h; D.qpitch = 1536; D.K = WSP(bf16_t, WS_K1N) + 64 * h; D.kpitch = DM; D.K2 = WSP(bf16_t, WS_KPE); D.k2pitch = 32;
        D.V = WSP(bf16_t, WS_V1) + 64 * h; D.vpitch = DM; D.G = WSP(bf16_t, WS_G1) + 64 * h; D.gpitch = DM; D.O = MIX + 64 * h; D.opitch = DM;
        D.qrow0 = (long)b * SEQ + qb * 256; D.lat_row0 = (long)b * SEQ; D.ntl = SEQ / 64; D.ctx_row0 = LROWS + (long)b * CTX; D.ntc = CTX / 64; D.band_q0 = 0; D.band_k0 = 0; D.sink = 0.f; D.has_sink = 0;
        att::unit<6, false>(D, (char*)lds);
    }
#else
    naive_stage<14>(p);
#endif
    GRID_SYNC();
#if OPT_GEMM
#if GSEL_OUT1
    { pg8::Gemm g{MIX, WSP(bf16_t, WS_WOUT1), LROWS, DM, DM}; pg8::StaticOrder S; S.init(LROWS, DM, G, bid);
      pg8::EpiOut E{p.out, p.out, nullptr, nullptr, MOD + 9 * 3072};
      pg8::gemm_phase<pg8::EpiOut, pg8::StaticOrder, true, true>(glds, g, S, E); }
#endif
#else
    naive_stage<15>(p);
#endif
    GRID_SYNC();
#if OPT_NORM
    for (long r = (long)bid * NWAVES + wid; r < LROWS; r += (long)G * NWAVES) thin::final_row(p, r, lane);
#else
    naive_stage<16>(p);
#endif
}

extern "C" void kernel_launch(void* const* d_in, const int* in_sizes, int n_in, void* d_out, int out_size, void* d_ws, size_t ws_size, hipStream_t stream) {
    if (n_in != 21 || ws_size < WS_END || out_size != LROWS * DM) { fprintf(stderr, "kernel_launch: unexpected sizes n_in %d out %d ws %zu (need %zu)\n", n_in, out_size, ws_size, (size_t)WS_END); return; }
    Params p{};
    const float** f = (const float**)&p;
    for (int i = 0; i < 21; ++i) f[i] = (const float*)d_in[i];
    p.out = (float*)d_out; p.ws = (unsigned char*)d_ws;
    static int grid_blocks = 0;
    if (!grid_blocks) {
        int dev = 0, cus = 0, per_cu = 0;
        hipGetDevice(&dev);
        hipDeviceGetAttribute(&cus, hipDeviceAttributeMultiprocessorCount, dev);
        if (hipFuncSetAttribute((const void*)k_fwd, hipFuncAttributeMaxDynamicSharedMemorySize, LDS_BYTES) != hipSuccess) fprintf(stderr, "kernel_launch: hipFuncSetAttribute(%d B dynamic LDS) failed\n", LDS_BYTES);
        hipOccupancyMaxActiveBlocksPerMultiprocessor(&per_cu, k_fwd, NTHREADS, LDS_BYTES);
        if (per_cu < 1) { fprintf(stderr, "kernel_launch: occupancy query says %d blocks/CU\n", per_cu); per_cu = 1; }
        grid_blocks = cus;
    }
    hipMemsetAsync((char*)d_ws + WS_MOD, 0, (size_t)2 * 9 * 3072 * 4, stream);
    void* args[] = {&p};
    hipError_t e = hipLaunchCooperativeKernel((void*)k_fwd, dim3(grid_blocks), dim3(NTHREADS), args, LDS_BYTES, stream);
    if (e != hipSuccess) fprintf(stderr, "cooperative launch failed: %s (grid %d)\n", hipGetErrorString(e), grid_blocks);
}
#else
static std::vector<float> readf(const char* path, size_t n) { std::vector<float> v(n); FILE* f = fopen(path, "rb"); if (!f) { printf("cannot open %s\n", path); exit(1); } size_t g = fread(v.data(), 4, n, f); fclose(f); if (g != n) { printf("short read %s %zu/%zu\n", path, g, n); exit(1); } return v; }
static void cmp(const char* name, const float* a, const float* b, size_t n) { double e = 0, s = 0, mx = 0; for (size_t i = 0; i < n; ++i) { double d = (double)a[i] - b[i]; e += d * d; s += (double)b[i] * b[i]; if (fabs(d) > mx) mx = fabs(d); }
    printf("%-8s rvr %.3e  rel %.3e  absmax %.3e  (ref rms %.4f)\n", name, e / s, sqrt(e / s), mx, sqrt(s / n)); }
int main(int argc, char** argv) {
    const char* dir = argc > 1 ? argv[1] : "data"; char path[512];
    const size_t sizes[21] = {(size_t)LROWS * DM, (size_t)NB * DM, (size_t)CROWS * DM, DM, 2 * DM, 2u * DM * 3072, 2 * 3072, (size_t)DM * N_IN0, 8, 512, 512, 8 * 128 * 128, 8 * 128, (size_t)DM * DM,
                              (size_t)DM * 1440, 256, 256 * 1536, 128, 128 * 2048, (size_t)DM * DM, DM};
    size_t tot = 0; for (int i = 0; i < 21; ++i) tot += sizes[i];
    snprintf(path, sizeof path, "%s/inputs.bin", dir); std::vector<float> in = readf(path, tot);
    Params p{}; const float** f = (const float**)&p; size_t off = 0; for (int i = 0; i < 21; ++i) { f[i] = in.data() + off; off += sizes[i]; }
    std::vector<float> out((size_t)LROWS * DM, NAN); std::vector<unsigned char> ws(WS_END, 0xAA); p.out = out.data(); p.ws = ws.data();
    auto dump_bf = [&](const char* nm, size_t wsoff, size_t rows, size_t pitch, size_t c0, size_t ncol, float scale) {
        snprintf(path, sizeof path, "%s/dbg_%s.bin", dir, nm); std::vector<float> ref = readf(path, rows * ncol); std::vector<float> mine(rows * ncol);
        const bf16_t* b = (const bf16_t*)(ws.data() + wsoff); for (size_t r = 0; r < rows; ++r) for (size_t c = 0; c < ncol; ++c) mine[r * ncol + c] = bf2f(b[r * pitch + c0 + c]) * scale; cmp(nm, mine.data(), ref.data(), rows * ncol); };
    for (int s = 0; s <= N_STAGES; ++s) {
        long n = stage_items(s);
#pragma omp parallel for schedule(dynamic, 256)
        for (long it = 0; it < n; ++it) stage_item(p, s, it);
        if (s == 3) {
            snprintf(path, sizeof path, "%s/dbg_h0.bin", dir); std::vector<float> ref = readf(path, (size_t)ROWS * DM); std::vector<float> mine((size_t)ROWS * DM); const bf16_t* H = (const bf16_t*)(ws.data() + WS_H);
            for (int b = 0; b < NB; ++b) for (int j = 0; j < SEQ + CTX; ++j) { size_t r = j < SEQ ? (size_t)b * SEQ + j : LROWS + (size_t)b * CTX + j - SEQ; for (int c = 0; c < DM; ++c) mine[((size_t)b * (SEQ + CTX) + j) * DM + c] = bf2f(H[r * DM + c]); }
            cmp("h0", mine.data(), ref.data(), mine.size()); }
        if (s == 4) { dump_bf("q0", WS_P0, LROWS, N_IN0, C_Q, 512, 1.0f / QSCALE0); dump_bf("k0", WS_P0, LROWS, N_IN0, C_K, 128, 1.0f); }
        if (s == 7) { snprintf(path, sizeof path, "%s/dbg_mix0.bin", dir); std::vector<float> ref = readf(path, (size_t)ROWS * DM); std::vector<float> mine((size_t)ROWS * DM); const bf16_t* H = (const bf16_t*)(ws.data() + WS_MIX);
            for (int b = 0; b < NB; ++b) for (int j = 0; j < SEQ + CTX; ++j) { size_t r = j < SEQ ? (size_t)b * SEQ + j : LROWS + (size_t)b * CTX + j - SEQ; for (int c = 0; c < DM; ++c) mine[((size_t)b * (SEQ + CTX) + j) * DM + c] = bf2f(H[r * DM + c]); }
            cmp("mix0", mine.data(), ref.data(), mine.size()); }
        if (s == 8) { snprintf(path, sizeof path, "%s/dbg_x1.bin", dir); std::vector<float> ref = readf(path, (size_t)LROWS * DM); cmp("x1", out.data(), ref.data(), ref.size()); }
        if (s == 9) { snprintf(path, sizeof path, "%s/dbg_h1.bin", dir); std::vector<float> ref = readf(path, (size_t)ROWS * DM); std::vector<float> mine((size_t)ROWS * DM); const bf16_t* H = (const bf16_t*)(ws.data() + WS_H);
            for (int b = 0; b < NB; ++b) for (int j = 0; j < SEQ + CTX; ++j) { size_t r = j < SEQ ? (size_t)b * SEQ + j : LROWS + (size_t)b * CTX + j - SEQ; for (int c = 0; c < DM; ++c) mine[((size_t)b * (SEQ + CTX) + j) * DM + c] = bf2f(H[r * DM + c]); }
            cmp("h1", mine.data(), ref.data(), mine.size()); }
        if (s == 12) {
            snprintf(path, sizeof path, "%s/dbg_q1.bin", dir); std::vector<float> ref = readf(path, (size_t)LROWS * 1536); std::vector<float> mine((size_t)LROWS * 1536); const bf16_t* Q = (const bf16_t*)(ws.data() + WS_Q1);
            for (size_t r = 0; r < (size_t)LROWS; ++r) for (int c = 0; c < 1536; ++c) { int h = c / 96, w = c % 96; int oc = h * 96 + (w < 64 ? w : 64 + pe_orig(w - 64)); mine[r * 1536 + oc] = bf2f(Q[r * 1536 + c]) / QSCALE1; }
            cmp("q1", mine.data(), ref.data(), mine.size()); }
        if (s == 15) { snprintf(path, sizeof path, "%s/dbg_x2.bin", dir); std::vector<float> ref = readf(path, (size_t)LROWS * DM); cmp("x2", out.data(), ref.data(), ref.size()); }
    }
    snprintf(path, sizeof path, "%s/out.bin", dir); std::vector<float> ref = readf(path, (size_t)LROWS * DM); cmp("out", out.data(), ref.data(), ref.size());
    return 0;
}
#endif
```

```cpp
#ifndef HOST_TEST
#include <hip/hip_runtime.h>
#include <hip/hip_cooperative_groups.h>
#include <cstdio>
#define HD __device__ __forceinline__
#else
#include <cstdio>
#include <cstdlib>
#include <cstring>
#include <cmath>
#include <vector>
#define HD static inline
#endif
#include <cstdint>

#ifndef CFG_B
#define CFG_B 8
#endif
#ifndef CFG_S
#define CFG_S 2048
#endif
#ifndef CFG_C
#define CFG_C 256
#endif
constexpr int NB = CFG_B, SEQ = CFG_S, CTX = CFG_C, DM = 1024, GRIDW = 64;
constexpr int LROWS = NB * SEQ, CROWS = NB * CTX, ROWS = LROWS + CROWS;
constexpr int N_IN0 = 2816, N_IN1 = 1536;
constexpr int C_Q = 0, C_K = 512, C_V = 640, C_U = 768, C_VV = 1280, C_G = 1792;
constexpr float LOG2E = 1.4426950408889634f;
constexpr float QSCALE0 = 0.125f * LOG2E;
constexpr float QSCALE1 = 0.10206207261596577f * LOG2E;
constexpr float NORM_EPS = 1e-6f;

typedef unsigned short bf16_t;

constexpr size_t al(size_t x) { return (x + 4095) & ~(size_t)4095; }
constexpr size_t WS_CTL = 0;
constexpr size_t WS_WIN0 = 1u << 20;
constexpr size_t WS_WOUT0 = WS_WIN0 + al((size_t)N_IN0 * DM * 2);
constexpr size_t WS_WIN1 = WS_WOUT0 + al((size_t)DM * DM * 2);
constexpr size_t WS_WQB = WS_WIN1 + al((size_t)N_IN1 * DM * 2);
constexpr size_t WS_WKVB = WS_WQB + al((size_t)1536 * 256 * 2);
constexpr size_t WS_WOUT1 = WS_WKVB + al((size_t)2048 * 256 * 2);
constexpr size_t WS_WS = WS_WOUT1 + al((size_t)DM * DM * 2);
constexpr size_t WS_MOD = WS_WS + al((size_t)8 * 128 * 128 * 2);
constexpr size_t WS_ROPE0 = WS_MOD + al((size_t)2 * 9 * 3072 * 4);
constexpr size_t WS_ROPE1 = WS_ROPE0 + al((size_t)SEQ * 32 * 2 * 4);
constexpr size_t WS_VVP = WS_ROPE1 + al((size_t)SEQ * 16 * 2 * 4);
constexpr size_t WS_QSP = WS_VVP + al((size_t)ROWS * 16 * 4);
constexpr size_t WS_KVSP = WS_QSP + al((size_t)LROWS * 4 * 4);
constexpr size_t WS_KPE = WS_KVSP + al((size_t)ROWS * 4 * 4);
constexpr size_t WS_KVA = WS_KPE + al((size_t)ROWS * 32 * 2);
constexpr size_t WS_X1C = WS_KVA + al((size_t)ROWS * 256 * 2);
constexpr size_t WS_H = WS_X1C + al((size_t)CROWS * DM * 4);
constexpr size_t WS_K1N = WS_H;
constexpr size_t WS_P0 = WS_H + al((size_t)ROWS * DM * 2);
constexpr size_t WS_Q1 = WS_P0;
constexpr size_t WS_G1 = WS_Q1 + al((size_t)LROWS * 1536 * 2);
constexpr size_t WS_QA = WS_G1 + al((size_t)LROWS * DM * 2);
constexpr size_t WS_MIX = WS_P0 + al((size_t)ROWS * N_IN0 * 2);
constexpr size_t WS_V1 = WS_MIX + al((size_t)ROWS * DM * 2);
constexpr size_t WS_END = WS_V1 + al((size_t)ROWS * DM * 2);
static_assert(WS_QA + (size_t)LROWS * 256 * 2 <= WS_MIX, "layer-1 overlay fits in P0");
static_assert(WS_END <= (size_t)256 << 20, "workspace fits in 256 MiB");

struct Params {
    const float *x, *c, *ctx, *c_ctx, *norm_g, *w_ada, *b_ada, *w_in0, *sink0, *gm_ln_g, *gm_ln_b, *gm_ws, *gm_bs, *w_out0,
        *w_in1, *q_norm, *w_qb, *kv_norm, *w_kvb, *w_out1, *final_g;
    float* out;
    unsigned char* ws;
};

HD float bf2f(bf16_t v) { unsigned u = (unsigned)v << 16; float f; memcpy(&f, &u, 4); return f; }
HD bf16_t f2bf(float f) { unsigned u; memcpy(&u, &f, 4); return (bf16_t)((u + 0x7fffu + ((u >> 16) & 1u)) >> 16); }
HD float silu_f(float v) { return v / (1.0f + expf(-v)); }
HD float gelu_f(float v) { return 0.5f * v * (1.0f + erff(v * 0.70710678118654752f)); }
HD int pe_orig(int p) { return p < 8 ? p : (p < 16 ? p + 8 : (p < 24 ? p - 8 : p)); }

#define WSP(T, off) ((T*)(p.ws + (off)))

constexpr long W_ITEMS0 = (long)N_IN0 * DM, W_ITEMS1 = (long)DM * DM, W_ITEMS2 = (long)N_IN1 * DM, W_ITEMS3 = 1536L * 256, W_ITEMS4 = 2048L * 256,
               W_ITEMS5 = (long)DM * DM, W_ITEMS6 = 8L * 128 * 128;
constexpr long W_ITEMS = W_ITEMS0 + W_ITEMS1 + W_ITEMS2 + W_ITEMS3 + W_ITEMS4 + W_ITEMS5 + W_ITEMS6;
HD void nk_weights(const Params& p, long it) {
    if (it < W_ITEMS0) { int n = (int)(it / DM), k = (int)(it % DM); WSP(bf16_t, WS_WIN0)[it] = f2bf(p.w_in0[(size_t)k * N_IN0 + n]); return; } it -= W_ITEMS0;
    if (it < W_ITEMS1) { int n = (int)(it / DM), k = (int)(it % DM); WSP(bf16_t, WS_WOUT0)[it] = f2bf(p.w_out0[(size_t)k * DM + n]); return; } it -= W_ITEMS1;
    if (it < W_ITEMS2) { int n = (int)(it / DM), k = (int)(it % DM); float v = 0.f;
        if (n < 416) v = p.w_in1[(size_t)k * 1440 + (n < 384 ? n : 384 + pe_orig(n - 384))]; else if (n >= 512) v = p.w_in1[(size_t)k * 1440 + n - 96];
        WSP(bf16_t, WS_WIN1)[it] = f2bf(v); return; } it -= W_ITEMS2;
    if (it < W_ITEMS3) { int n = (int)(it / 256), k = (int)(it % 256); int h = n / 96, w = n % 96; int oc = h * 96 + (w < 64 ? w : 64 + pe_orig(w - 64));
        WSP(bf16_t, WS_WQB)[it] = f2bf(p.w_qb[(size_t)k * 1536 + oc] * p.q_norm[k]); return; } it -= W_ITEMS3;
    if (it < W_ITEMS4) { int n = (int)(it / 256), k = (int)(it % 256); int nn = n & 1023, h = nn >> 6, d = nn & 63; int oc = h * 128 + d + (n >= 1024 ? 64 : 0);
        WSP(bf16_t, WS_WKVB)[it] = k < 128 ? f2bf(p.w_kvb[(size_t)k * 2048 + oc] * p.kv_norm[k]) : (bf16_t)0; return; } it -= W_ITEMS4;
    if (it < W_ITEMS5) { int n = (int)(it / DM), k = (int)(it % DM); WSP(bf16_t, WS_WOUT1)[it] = f2bf(p.w_out1[(size_t)k * DM + n]); return; } it -= W_ITEMS5;
    WSP(bf16_t, WS_WS)[it] = f2bf(p.gm_ws[it]);
}
constexpr long ROPE_ITEMS = (long)SEQ * 48;
HD void nk_rope(const Params& p, long it) {
    int s = (int)(it / 48), t = (int)(it % 48); float pr = (float)(s / GRIDW), pc = (float)(s % GRIDW);
    if (t < 32) { int j = t & 15; float inv = exp2f(-(float)j * (13.287712379549449f / 16.0f)); float a = (t < 16 ? pr : pc) * inv;
        float* o = WSP(float, WS_ROPE0) + ((size_t)s * 32 + t) * 2; o[0] = cosf(a); o[1] = sinf(a); }
    else { int u = t - 32, j = u & 7; float inv = exp2f(-(float)j * (13.287712379549449f / 8.0f)); float a = (u < 8 ? pr : pc) * inv;
        float* o = WSP(float, WS_ROPE1) + ((size_t)s * 16 + u) * 2; o[0] = cosf(a); o[1] = sinf(a); }
}
constexpr long ADA_ITEMS = 2L * 3072;
HD void nk_adaln(const Params& p, long it) {
    int l = (int)(it / 3072), n = (int)(it % 3072); float acc[9];
#pragma unroll
    for (int r = 0; r < 9; ++r) acc[r] = 0.f;
    const float* w = p.w_ada + (size_t)l * DM * 3072 + n;
    for (int k = 0; k < DM; ++k) { float wv = w[(size_t)k * 3072];
#pragma unroll
        for (int r = 0; r < 9; ++r) { float cv = (r < 8) ? (r < NB ? p.c[r * DM + k] : 0.f) : p.c_ctx[k]; acc[r] += silu_f(cv) * wv; } }
    float bb = p.b_ada[l * 3072 + n];
#pragma unroll
    for (int r = 0; r < 9; ++r) WSP(float, WS_MOD)[((size_t)l * 9 + r) * 3072 + n] = acc[r] + bb;
}
HD void nk_modnorm(const Params& p, long r, int layer) {
    const float* src; int mr;
    if (r < LROWS) { src = (layer == 0 ? p.x : p.out) + (size_t)r * DM; mr = (int)(r / SEQ); }
    else { src = (layer == 0 ? p.ctx : WSP(float, WS_X1C)) + (size_t)(r - LROWS) * DM; mr = 8; }
    float ss = 0.f; for (int k = 0; k < DM; ++k) ss += src[k] * src[k];
    float rstd = 1.0f / sqrtf(ss / DM + NORM_EPS);
    const float* md = WSP(float, WS_MOD) + ((size_t)layer * 9 + mr) * 3072; const float* g = p.norm_g + layer * DM;
    bf16_t* o = WSP(bf16_t, WS_H) + (size_t)r * DM;
    for (int k = 0; k < DM; ++k) o[k] = f2bf(src[k] * rstd * g[k] * (1.0f + md[1024 + k]) + md[k]);
}
HD float nk_dot(const bf16_t* a, const bf16_t* b, int K) { float s = 0.f; for (int k = 0; k < K; ++k) s += bf2f(a[k]) * bf2f(b[k]); return s; }
constexpr long IN0_ITEMS = (long)ROWS * N_IN0;
HD void nk_in0(const Params& p, long it) {
    long r = it / N_IN0; int c = (int)(it % N_IN0);
    const bf16_t* a = WSP(bf16_t, WS_H) + (size_t)r * DM; const bf16_t* W = WSP(bf16_t, WS_WIN0);
    float v = nk_dot(a, W + (size_t)c * DM, DM), o;
    if (c < C_V) {
        if (r < LROWS) { int d = c & 63, t = d & 15, second = (d >> 4) & 1, ax = d >> 5; int pc = second ? c - 16 : c + 16;
            float v2 = nk_dot(a, W + (size_t)pc * DM, DM); int s = (int)(r % SEQ); const float* cs = WSP(float, WS_ROPE0) + ((size_t)s * 32 + ax * 16 + t) * 2;
            o = second ? (v2 * cs[1] + v * cs[0]) : (v * cs[0] - v2 * cs[1]); }
        else o = v;
        if (c < C_K) o *= QSCALE0;
    } else if (c < C_U) o = v;
    else if (c < C_G) o = gelu_f(v);
    else o = silu_f(v);
    WSP(bf16_t, WS_P0)[it] = f2bf(o);
}
constexpr long VVP_ITEMS = (long)ROWS * 8;
HD void nk_vvp(const Params& p, long it) {
    long r = it / 8; int j = (int)(it % 8); const bf16_t* v = WSP(bf16_t, WS_P0) + (size_t)r * N_IN0 + C_VV + 64 * j; float s = 0.f, q = 0.f;
    for (int i = 0; i < 64; ++i) { float f = bf2f(v[i]); s += f; q += f * f; }
    float* o = WSP(float, WS_VVP) + it * 2; o[0] = s; o[1] = q;
}
constexpr long ATT0_ITEMS = (long)ROWS * 8;
HD void nk_attn0(const Params& p, long it) {
    int h = (int)(it / ROWS); long r = it % ROWS; int hk = h >> 2;
    const bf16_t* P0 = WSP(bf16_t, WS_P0); const bf16_t* qp = P0 + (size_t)r * N_IN0 + C_Q + 64 * h;
    float q[64], o[64];
#pragma unroll
    for (int d = 0; d < 64; ++d) { q[d] = bf2f(qp[d]); o[d] = 0.f; }
    float m = -1e30f, l = 0.f;
    int b, j0 = 0, j1 = 0; long cbase;
    if (r < LROWS) { b = (int)(r / SEQ); int s = (int)(r % SEQ); j0 = s - 128 < 0 ? 0 : s - 128; j1 = s + 128 > SEQ - 1 ? SEQ - 1 : s + 128; }
    else { b = (int)((r - LROWS) / CTX); j0 = 1; j1 = 0; }
    cbase = LROWS + (long)b * CTX;
    const int nloc = j1 - j0 + 1 > 0 ? j1 - j0 + 1 : 0;
    for (int t = 0; t < nloc + CTX; ++t) {
        long kr = t < nloc ? (long)b * SEQ + j0 + t : cbase + (t - nloc);
        const bf16_t* kp = P0 + (size_t)kr * N_IN0 + C_K + 64 * hk; const bf16_t* vp = P0 + (size_t)kr * N_IN0 + C_V + 64 * hk;
        float s = 0.f;
#pragma unroll
        for (int d = 0; d < 64; ++d) s += q[d] * bf2f(kp[d]);
        float mn = s > m ? s : m, a = exp2f(m - mn), pp = exp2f(s - mn); l = l * a + pp; m = mn;
#pragma unroll
        for (int d = 0; d < 64; ++d) o[d] = o[d] * a + pp * bf2f(vp[d]);
    }
    { float s = p.sink0[h] * LOG2E; float mn = s > m ? s : m, a = exp2f(m - mn), pp = exp2f(s - mn); l = l * a + pp;
#pragma unroll
      for (int d = 0; d < 64; ++d) o[d] *= a; }
    const bf16_t* gp = P0 + (size_t)r * N_IN0 + C_G + 64 * h; bf16_t* op = WSP(bf16_t, WS_MIX) + (size_t)r * DM + 64 * h; float rl = 1.0f / l;
#pragma unroll
    for (int d = 0; d < 64; ++d) op[d] = f2bf(o[d] * rl * bf2f(gp[d]));
}
constexpr long GMLP_ITEMS = (long)ROWS * 512;
HD void nk_gmlp(const Params& p, long it) {
    long r = it / 512; int c = (int)(it % 512), g = c >> 6, pp = (int)(r & 127); long r0 = r - pp;
    const bf16_t* P0 = WSP(bf16_t, WS_P0); const bf16_t* W = WSP(bf16_t, WS_WS) + ((size_t)g * 128 + pp) * 128; const float* vvp = WSP(float, WS_VVP);
    float lg = p.gm_ln_g[c], lb = p.gm_ln_b[c], s = 0.f;
    for (int q = 0; q < 128; ++q) { const float* pt = vvp + (size_t)(r0 + q) * 16; float sm = 0.f, sq = 0.f;
        for (int j = 0; j < 8; ++j) { sm += pt[2 * j]; sq += pt[2 * j + 1]; }
        float mean = sm * (1.0f / 512), var = sq * (1.0f / 512) - mean * mean, rstd = 1.0f / sqrtf(var + NORM_EPS);
        float vn = bf2f(f2bf((bf2f(P0[(size_t)(r0 + q) * N_IN0 + C_VV + c]) - mean) * rstd * lg + lb));
        s += bf2f(W[q]) * vn; }
    s += p.gm_bs[g * 128 + pp];
    float u = bf2f(P0[(size_t)r * N_IN0 + C_U + c]), gt = bf2f(P0[(size_t)r * N_IN0 + C_G + 512 + c]);
    WSP(bf16_t, WS_MIX)[(size_t)r * DM + 512 + c] = f2bf(u * s * gt);
}
constexpr long OUT0_ITEMS = (long)ROWS * DM;
HD void nk_out0(const Params& p, long it) {
    long r = it / DM; int c = (int)(it % DM);
    float y = nk_dot(WSP(bf16_t, WS_MIX) + (size_t)r * DM, WSP(bf16_t, WS_WOUT0) + (size_t)c * DM, DM);
    if (r < LROWS) { int b = (int)(r / SEQ); p.out[it] = p.x[it] + WSP(float, WS_MOD)[(size_t)b * 3072 + 2048 + c] * y; }
    else { size_t ci = (size_t)(r - LROWS) * DM + c; WSP(float, WS_X1C)[ci] = p.ctx[ci] + WSP(float, WS_MOD)[(size_t)8 * 3072 + 2048 + c] * y; }
}
constexpr long IN1_ITEMS = (long)ROWS * N_IN1;
HD void nk_in1(const Params& p, long it) {
    long r = it / N_IN1; int c = (int)(it % N_IN1);
    if (c >= 384 && c < 512) WSP(bf16_t, WS_KVA)[(size_t)r * 256 + 128 + c - 384] = 0;
    if (c >= 416 && c < 512) return;
    if (r >= LROWS && (c < 256 || c >= 416)) return;
    const bf16_t* a = WSP(bf16_t, WS_H) + (size_t)r * DM; const bf16_t* W = WSP(bf16_t, WS_WIN1);
    float v = nk_dot(a, W + (size_t)c * DM, DM);
    if (c < 256) WSP(bf16_t, WS_QA)[(size_t)r * 256 + c] = f2bf(v);
    else if (c < 384) WSP(bf16_t, WS_KVA)[(size_t)r * 256 + c - 256] = f2bf(v);
    else if (c < 416) { int pp = c - 384; float o = v;
        if (r < LROWS) { int second = pp >> 4, t = pp & 15; int pc = second ? c - 16 : c + 16; float v2 = nk_dot(a, W + (size_t)pc * DM, DM);
            int s = (int)(r % SEQ); const float* cs = WSP(float, WS_ROPE1) + ((size_t)s * 16 + t) * 2;
            o = second ? (v2 * cs[1] + v * cs[0]) : (v * cs[0] - v2 * cs[1]); }
        WSP(bf16_t, WS_KPE)[(size_t)r * 32 + pp] = f2bf(o); }
    else WSP(bf16_t, WS_G1)[(size_t)r * DM + c - 512] = f2bf(silu_f(v));
}
constexpr long SSP_ITEMS = (long)ROWS * 8;
HD void nk_ssp(const Params& p, long it) {
    long r = it / 8; int j = (int)(it % 8);
    if (j < 4) { if (r >= LROWS) return; const bf16_t* v = WSP(bf16_t, WS_QA) + (size_t)r * 256 + 64 * j; float q = 0.f; for (int i = 0; i < 64; ++i) { float f = bf2f(v[i]); q += f * f; }
        WSP(float, WS_QSP)[r * 4 + j] = q; }
    else { j -= 4; const bf16_t* v = WSP(bf16_t, WS_KVA) + (size_t)r * 256 + 32 * j; float q = 0.f; for (int i = 0; i < 32; ++i) { float f = bf2f(v[i]); q += f * f; }
        WSP(float, WS_KVSP)[r * 4 + j] = q; }
}
constexpr long QB_ITEMS = (long)LROWS * 1536;
HD void nk_qb(const Params& p, long it) {
    long r = it / 1536; int c = (int)(it % 1536); int w = c % 96;
    const bf16_t* a = WSP(bf16_t, WS_QA) + (size_t)r * 256; const bf16_t* W = WSP(bf16_t, WS_WQB);
    const float* sp = WSP(float, WS_QSP) + r * 4; float rstd = 1.0f / sqrtf((sp[0] + sp[1] + sp[2] + sp[3]) * (1.0f / 256) + NORM_EPS);
    float v = nk_dot(a, W + (size_t)c * 256, 256) * rstd, o = v;
    if (w >= 64) { int pp = w - 64, second = pp >> 4, t = pp & 15; int pc = second ? c - 16 : c + 16; float v2 = nk_dot(a, W + (size_t)pc * 256, 256) * rstd;
        int s = (int)(r % SEQ); const float* cs = WSP(float, WS_ROPE1) + ((size_t)s * 16 + t) * 2;
        o = second ? (v2 * cs[1] + v * cs[0]) : (v * cs[0] - v2 * cs[1]); }
    WSP(bf16_t, WS_Q1)[it] = f2bf(o * QSCALE1);
}
constexpr long KVB_ITEMS = (long)ROWS * 2048;
HD void nk_kvb(const Params& p, long it) {
    long r = it / 2048; int c = (int)(it % 2048);
    const float* sp = WSP(float, WS_KVSP) + r * 4; float rstd = 1.0f / sqrtf((sp[0] + sp[1] + sp[2] + sp[3]) * (1.0f / 128) + NORM_EPS);
    float v = nk_dot(WSP(bf16_t, WS_KVA) + (size_t)r * 256, WSP(bf16_t, WS_WKVB) + (size_t)c * 256, 256) * rstd;
    if (c < 1024) WSP(bf16_t, WS_K1N)[(size_t)r * DM + c] = f2bf(v); else WSP(bf16_t, WS_V1)[(size_t)r * DM + c - 1024] = f2bf(v);
}
constexpr long ATT1_ITEMS = (long)LROWS * 16;
HD void nk_attn1(const Params& p, long it) {
    int h = (int)(it / LROWS); long r = it % LROWS; int b = (int)(r / SEQ);
    const bf16_t* qp = WSP(bf16_t, WS_Q1) + (size_t)r * 1536 + 96 * h;
    float q[96], o[64];
#pragma unroll
    for (int d = 0; d < 96; ++d) q[d] = bf2f(qp[d]);
#pragma unroll
    for (int d = 0; d < 64; ++d) o[d] = 0.f;
    float m = -1e30f, l = 0.f;
    for (int t = 0; t < SEQ + CTX; ++t) {
        long kr = t < SEQ ? (long)b * SEQ + t : LROWS + (long)b * CTX + (t - SEQ);
        const bf16_t* kn = WSP(bf16_t, WS_K1N) + (size_t)kr * DM + 64 * h; const bf16_t* kp = WSP(bf16_t, WS_KPE) + (size_t)kr * 32; const bf16_t* vp = WSP(bf16_t, WS_V1) + (size_t)kr * DM + 64 * h;
        float s = 0.f;
#pragma unroll
        for (int d = 0; d < 64; ++d) s += q[d] * bf2f(kn[d]);
#pragma unroll
        for (int d = 0; d < 32; ++d) s += q[64 + d] * bf2f(kp[d]);
        float mn = s > m ? s : m, a = exp2f(m - mn), pp = exp2f(s - mn); l = l * a + pp; m = mn;
#pragma unroll
        for (int d = 0; d < 64; ++d) o[d] = o[d] * a + pp * bf2f(vp[d]);
    }
    const bf16_t* gp = WSP(bf16_t, WS_G1) + (size_t)r * DM + 64 * h; bf16_t* op = WSP(bf16_t, WS_MIX) + (size_t)r * DM + 64 * h; float rl = 1.0f / l;
#pragma unroll
    for (int d = 0; d < 64; ++d) op[d] = f2bf(o[d] * rl * bf2f(gp[d]));
}
constexpr long OUT1_ITEMS = (long)LROWS * DM;
HD void nk_out1(const Params& p, long it) {
    long r = it / DM; int c = (int)(it % DM); int b = (int)(r / SEQ);
    float y = nk_dot(WSP(bf16_t, WS_MIX) + (size_t)r * DM, WSP(bf16_t, WS_WOUT1) + (size_t)c * DM, DM);
    p.out[it] = p.out[it] + WSP(float, WS_MOD)[((size_t)9 + b) * 3072 + 2048 + c] * y;
}
HD void nk_final(const Params& p, long r) {
    float* o = p.out + (size_t)r * DM; float ss = 0.f; for (int k = 0; k < DM; ++k) ss += o[k] * o[k];
    float rstd = 1.0f / sqrtf(ss / DM + NORM_EPS);
    for (int k = 0; k < DM; ++k) o[k] = o[k] * rstd * p.final_g[k];
}

constexpr int N_STAGES = 16;
#ifndef HOST_TEST
__host__ __device__ inline
#else
static inline
#endif
long stage_items(int s) {
    switch (s) { case 0: return W_ITEMS; case 1: return ROPE_ITEMS; case 2: return ADA_ITEMS; case 3: return ROWS; case 4: return IN0_ITEMS; case 5: return VVP_ITEMS;
        case 6: return ATT0_ITEMS; case 7: return GMLP_ITEMS; case 8: return OUT0_ITEMS; case 9: return ROWS; case 10: return IN1_ITEMS; case 11: return SSP_ITEMS;
        case 12: return QB_ITEMS; case 13: return KVB_ITEMS; case 14: return ATT1_ITEMS; case 15: return OUT1_ITEMS; default: return LROWS; }
}
HD void stage_item(const Params& p, int s, long it) {
    switch (s) { case 0: nk_weights(p, it); break; case 1: nk_rope(p, it); break; case 2: nk_adaln(p, it); break; case 3: nk_modnorm(p, it, 0); break; case 4: nk_in0(p, it); break;
        case 5: nk_vvp(p, it); break; case 6: nk_attn0(p, it); break; case 7: nk_gmlp(p, it); break; case 8: nk_out0(p, it); break; case 9: nk_modnorm(p, it, 1); break;
        case 10: nk_in1(p, it); break; case 11: nk_ssp(p, it); break; case 12: nk_qb(p, it); break; case 13: nk_kvb(p, it); break; case 14: nk_attn1(p, it); break;
        case 15: nk_out1(p, it); break; default: nk_final(p, it); break; }
}
HD bool stage_sync_after(int s) { return !(s == 0 || s == 1 || s == 6 || s == 12); }

#ifndef HOST_TEST
#include <hip/hip_bf16.h>
__device__ __forceinline__ int lane_id() { return (int)__builtin_amdgcn_mbcnt_hi(~0u, __builtin_amdgcn_mbcnt_lo(~0u, 0u)); }
__device__ __forceinline__ int tid_rebuilt() { return __builtin_amdgcn_readfirstlane((int)threadIdx.x >> 6) * 64 + lane_id(); }
namespace pg8 {
#define PG8_LAS __attribute__((address_space(3)))
typedef unsigned short bf16_t;
typedef short bf16x8 __attribute__((ext_vector_type(8)));
typedef float f32x4 __attribute__((ext_vector_type(4)));
typedef unsigned u32x4 __attribute__((ext_vector_type(4)));
constexpr int BM = 256, BK = 64, HALF = 128, HTB = HALF * BK * 2  , STAGE_BYTES = 8 * HTB, NXCD = 8, WGM = 8;

__host__ __device__ __forceinline__ int lds_byte(int r, int c) { const int st = (r >> 4) * 2 + (c >> 5), rr = r & 15, cc = c & 31, ob = rr * 64 + cc * 2; return st * 1024 + (ob ^ (((ob >> 9) & 1) << 5)); }
__host__ __device__ __forceinline__ void stage_rc(int b, int& R, int& C) { const int st = b / 1024, sb = b % 1024, swz = sb ^ (((sb >> 9) & 1) << 5); R = (st >> 1) * 16 + swz / 64; C = (st & 1) * 32 + (swz % 64) / 2; }
__host__ __device__ __forceinline__ int perm32(int rho) { const int n = rho >> 4, i = rho & 15; return 8 * (i >> 2) + 4 * n + (i & 3); }

struct Unit { int pm, pn; };
struct Gemm { const bf16_t* A; const bf16_t* Bt; int M, N, K; };
struct StaticOrder {
    int nM, nN, nwg, G, c;
    __host__ __device__ void init(int M, int N, int G_, int c_) { nM = M / BM; nN = N / BM; nwg = nM * nN; G = G_; c = c_; }
    __host__ __device__ bool next(int i, Unit& u) const {
        const long L = (long)i * G + c; if (L >= nwg) return false;
        int wgid = (int)L; { const int q = nwg / NXCD, r = nwg % NXCD, xcd = wgid % NXCD, off = wgid / NXCD; wgid = (xcd < r ? xcd * (q + 1) : r * (q + 1) + (xcd - r) * q) + off; }
        const int nig = WGM * nN, gid = wgid / nig, fm = gid * WGM, gsz = (nM - fm) < WGM ? (nM - fm) : WGM;
        u.pm = fm + ((wgid % nig) % gsz); u.pn = (wgid % nig) / gsz; return true;
    }
    __device__ __forceinline__ void a_ready(const Unit&) const {}
    __device__ __forceinline__ void done(const Unit&) const {}
};
__device__ __forceinline__ unsigned cvt_pk_bf16(float lo, float hi) { unsigned r; asm volatile("v_cvt_pk_bf16_f32 %0, %1, %2" : "=v"(r) : "v"(lo), "v"(hi)); return r; }
typedef float f32x2 __attribute__((ext_vector_type(2)));
template <class Epi, class Sched, bool ALIGN_EPI = false, bool SP2 = false>
__device__ __forceinline__ void gemm_phase(PG8_LAS unsigned char* lds, const Gemm g, const Sched& S, const Epi& E) {
    int tid_ = tid_rebuilt(); asm volatile("" : "+v"(tid_));
    const int tid = tid_, wid = __builtin_amdgcn_readfirstlane(tid >> 6), lane = tid & 63, wr = wid >> 2, wc = wid & 3, fr = lane & 15, fq = lane >> 4;
    int K_ = g.K; asm volatile("" : "+s"(K_));
    const int K = K_, nt = K / BK;
    unsigned voffA[2], voffB[2];
#pragma unroll
    for (int i = 0; i < 2; ++i) { int R, C; stage_rc(tid * 16 + i * 8192, R, C); const int Rb = Epi::PERM ? ((R & ~31) + perm32(R & 31)) : R;
        voffA[i] = (unsigned)(R * K + C) * 2u; voffB[i] = (unsigned)(Rb * K + C) * 2u; }
    const size_t kstep = (size_t)(BK * 2);
    const size_t hstep = (size_t)HALF * K * 2;
    const size_t tstep = 2 * hstep;
    const unsigned ldsw = (unsigned)wid * 1024u;
    const int aoff = lds_byte(wr * 64 + fr, fq * 8), boff = lds_byte(wc * 32 + fr, fq * 8);
#define PG8_SA(b, h) (((b) * 2 + (h)) * HTB)
#define PG8_SB(b, h) ((4 + (b) * 2 + (h)) * HTB)
#define PG8_STAGE(bufoff, gbase, voff) do { _Pragma("unroll") for (int _i = 0; _i < 2; ++_i) \
        __builtin_amdgcn_global_load_lds((const unsigned*)((const char*)(gbase) + (voff)[_i]), (PG8_LAS unsigned*)(lds + (bufoff) + ldsw + _i * 8192), 16, 0, 0); } while (0)
#define PG8_LDA(dst, b, h) do { _Pragma("unroll") for (int m = 0; m < 4; ++m) _Pragma("unroll") for (int k = 0; k < 2; ++k) dst[m][k] = *(const PG8_LAS bf16x8*)(lds + PG8_SA(b, h) + aoff + m * 2048 + k * 1024); } while (0)
#define PG8_LDB(dst, b, h) do { _Pragma("unroll") for (int n = 0; n < 2; ++n) _Pragma("unroll") for (int k = 0; k < 2; ++k) dst[n][k] = *(const PG8_LAS bf16x8*)(lds + PG8_SB(b, h) + boff + n * 2048 + k * 1024); } while (0)
#define PG8_MMA(ai, bj, At, Bt) do { __builtin_amdgcn_s_setprio(1); _Pragma("unroll") for (int m = 0; m < 4; ++m) _Pragma("unroll") for (int n = 0; n < 2; ++n) _Pragma("unroll") for (int k = 0; k < 2; ++k) \
        acc[ai][bj][m][n] = __builtin_amdgcn_mfma_f32_16x16x32_bf16(Bt[n][k], At[m][k], acc[ai][bj][m][n], 0, 0, 0); __builtin_amdgcn_s_setprio(0); } while (0)
#define PG8_WAIT_V(n) asm volatile("s_waitcnt vmcnt(" #n ")" ::: "memory")
#define PG8_WAIT_L(n) asm volatile("s_waitcnt lgkmcnt(" #n ")" ::: "memory")
#define PG8_BAR __builtin_amdgcn_s_barrier()
#define PG8_SCHED __builtin_amdgcn_sched_barrier(0)
    Unit cur, nxt; int ui = 0;
    if (!S.next(0, cur)) return;
    f32x4 acc[2][2][4][2];
#pragma unroll
    for (int a = 0; a < 2; ++a)
#pragma unroll
        for (int b = 0; b < 2; ++b)
#pragma unroll
            for (int m = 0; m < 4; ++m)
#pragma unroll
                for (int n = 0; n < 2; ++n) acc[a][b][m][n] = (f32x4){0.f, 0.f, 0.f, 0.f};
    bf16x8 At[4][2], B0[2][2], B1[2][2];
    const char* cA = (const char*)g.A + (size_t)cur.pm * tstep; const char* cB = (const char*)g.Bt + (size_t)cur.pn * tstep;
    S.a_ready(cur);
    if constexpr (SP2) {
        PG8_STAGE(PG8_SB(0, 0), cB, voffB); PG8_STAGE(PG8_SB(0, 1), cB + hstep, voffB); PG8_STAGE(PG8_SA(0, 0), cA, voffA); PG8_STAGE(PG8_SA(0, 1), cA + hstep, voffA);
        if (wr == 1) PG8_BAR;
        PG8_WAIT_V(2); PG8_BAR;
        PG8_STAGE(PG8_SB(1, 0), cB + kstep, voffB); PG8_STAGE(PG8_SA(1, 0), cA + kstep, voffA); PG8_STAGE(PG8_SB(1, 1), cB + hstep + kstep, voffB);
        PG8_WAIT_V(6); PG8_BAR;
    } else {
        PG8_STAGE(PG8_SB(0, 0), cB, voffB); PG8_STAGE(PG8_SA(0, 0), cA, voffA); PG8_STAGE(PG8_SB(0, 1), cB + hstep, voffB); PG8_STAGE(PG8_SA(0, 1), cA + hstep, voffA);
        if (wr == 1) PG8_BAR;
        PG8_WAIT_V(4); PG8_BAR;
        PG8_STAGE(PG8_SB(1, 0), cB + kstep, voffB); PG8_STAGE(PG8_SA(1, 0), cA + kstep, voffA); PG8_STAGE(PG8_SB(1, 1), cB + hstep + kstep, voffB);
        PG8_WAIT_V(6); PG8_BAR;
    }
    for (;;) {
        const bool has_next = S.next(ui + 1, nxt);
        const char* nA = has_next ? (const char*)g.A + (size_t)nxt.pm * tstep : cA; const char* nB = has_next ? (const char*)g.Bt + (size_t)nxt.pn * tstep : cB;
        for (int t = 0; t < nt; t += 2) {
            const bool last = (t == nt - 2);
            const char* a1 = cA + (size_t)(t + 1) * kstep;
            const char* a2 = last ? nA : cA + (size_t)(t + 2) * kstep; const char* b2 = last ? nB : cB + (size_t)(t + 2) * kstep;
            const char* a3 = a2 + kstep; const char* b3 = b2 + kstep;
            if (last && has_next) S.a_ready(nxt);
            if constexpr (SP2) {
            PG8_LDB(B0, 0, 0); PG8_LDB(B1, 0, 1); PG8_SCHED; PG8_LDA(At, 0, 0); PG8_STAGE(PG8_SA(1, 1), a1 + hstep, voffA);
            PG8_WAIT_V(8); PG8_WAIT_L(0); PG8_BAR; PG8_MMA(0, 0, At, B0); PG8_MMA(0, 1, At, B1); PG8_BAR; PG8_SCHED;
            PG8_LDA(At, 0, 1); PG8_STAGE(PG8_SB(0, 0), b2, voffB); PG8_STAGE(PG8_SB(0, 1), b2 + hstep, voffB); PG8_STAGE(PG8_SA(0, 0), a2, voffA);
            PG8_WAIT_V(8); PG8_WAIT_L(0); PG8_BAR; PG8_MMA(1, 0, At, B0); PG8_MMA(1, 1, At, B1); PG8_BAR; PG8_SCHED;
            PG8_LDB(B0, 1, 0); PG8_LDB(B1, 1, 1); PG8_SCHED; PG8_LDA(At, 1, 0); PG8_STAGE(PG8_SA(0, 1), a2 + hstep, voffA);
            PG8_WAIT_V(8); PG8_WAIT_L(0); PG8_BAR; PG8_MMA(0, 0, At, B0); PG8_MMA(0, 1, At, B1); PG8_BAR; PG8_SCHED;
            PG8_LDA(At, 1, 1); PG8_STAGE(PG8_SB(1, 0), b3, voffB); PG8_STAGE(PG8_SB(1, 1), b3 + hstep, voffB); PG8_STAGE(PG8_SA(1, 0), a3, voffA);
            PG8_WAIT_V(8); PG8_WAIT_L(0); PG8_BAR; PG8_MMA(1, 0, At, B0); PG8_MMA(1, 1, At, B1); PG8_BAR; PG8_SCHED;
            } else {
            PG8_LDB(B0, 0, 0); PG8_SCHED; PG8_LDA(At, 0, 0); PG8_STAGE(PG8_SA(1, 1), a1 + hstep, voffA);
            PG8_WAIT_L(8); PG8_BAR; PG8_WAIT_L(0); PG8_MMA(0, 0, At, B0); PG8_BAR; PG8_SCHED;
            PG8_LDB(B1, 0, 1); PG8_STAGE(PG8_SB(0, 0), b2, voffB);
            PG8_BAR; PG8_WAIT_L(0); PG8_MMA(0, 1, At, B1); PG8_BAR;
            PG8_LDA(At, 0, 1); PG8_STAGE(PG8_SA(0, 0), a2, voffA);
            PG8_BAR; PG8_WAIT_L(0); PG8_MMA(1, 0, At, B0); PG8_BAR; PG8_SCHED;
            PG8_STAGE(PG8_SB(0, 1), b2 + hstep, voffB);
            PG8_WAIT_V(6); PG8_BAR; PG8_MMA(1, 1, At, B1); PG8_BAR;
            PG8_LDB(B0, 1, 0); PG8_SCHED; PG8_LDA(At, 1, 0); PG8_STAGE(PG8_SA(0, 1), a2 + hstep, voffA);
            PG8_WAIT_L(8); PG8_BAR; PG8_WAIT_L(0); PG8_MMA(0, 0, At, B0); PG8_BAR; PG8_SCHED;
            PG8_LDB(B1, 1, 1); PG8_STAGE(PG8_SB(1, 0), b3, voffB);
            PG8_BAR; PG8_WAIT_L(0); PG8_MMA(0, 1, At, B1); PG8_BAR;
            PG8_LDA(At, 1, 1); PG8_STAGE(PG8_SA(1, 0), a3, voffA);
            PG8_BAR; PG8_WAIT_L(0); PG8_MMA(1, 0, At, B0); PG8_BAR; PG8_SCHED;
            PG8_STAGE(PG8_SB(1, 1), b3 + hstep, voffB);
            PG8_WAIT_V(6); PG8_BAR; PG8_MMA(1, 1, At, B1); PG8_BAR;
            }
        }
        if constexpr (ALIGN_EPI) { if (wr == 0) PG8_BAR; }
        if constexpr (!Epi::AFTER_DRAIN) { E(acc, cur, wr, wc, fr, fq); S.done(cur); }
        if (!has_next) break;
#pragma unroll
        for (int a = 0; a < 2; ++a)
#pragma unroll
            for (int b = 0; b < 2; ++b)
#pragma unroll
                for (int m = 0; m < 4; ++m)
#pragma unroll
                    for (int n = 0; n < 2; ++n) acc[a][b][m][n] = (f32x4){0.f, 0.f, 0.f, 0.f};
        cur = nxt; cA = nA; cB = nB; ++ui;
        if constexpr (ALIGN_EPI) { if (wr == 1) PG8_BAR; }
    }
    PG8_WAIT_V(0);
    if constexpr (!ALIGN_EPI) { if (wr == 0) PG8_BAR; }
    PG8_BAR;
    if constexpr (Epi::AFTER_DRAIN) { E.fused(acc, cur, wr, wc, fr, fq, lds, wid, lane); S.done(cur); }
#undef PG8_SA
#undef PG8_SB
#undef PG8_STAGE
#undef PG8_LDA
#undef PG8_LDB
#undef PG8_MMA
#undef PG8_WAIT_V
#undef PG8_WAIT_L
#undef PG8_BAR
#undef PG8_SCHED
}
}
namespace pg8 {
struct ExtOrder : StaticOrder {
    int n_extra, pm0, pn_extra;
    __device__ __forceinline__ void init2(int M, int N, int G_, int c_, int n_extra_, int pm0_, int pn_extra_) { init(M, N, G_, c_); n_extra = n_extra_; pm0 = pm0_; pn_extra = pn_extra_; }
    __device__ __forceinline__ bool next(int i, Unit& u) const {
        const long L = (long)i * G + c; if (L < nwg) return StaticOrder::next(i, u);
        const long e = L - nwg; if (e >= n_extra) return false; u.pm = pm0 + (int)e; u.pn = pn_extra; return true;
    }
};
typedef unsigned u32x2 __attribute__((ext_vector_type(2)));
__device__ __forceinline__ f32x2 gelu_pk(f32x2 v) {
    const f32x2 av = __builtin_elementwise_abs(v), d = av * 0.2316418882f + 1.0f;
    f32x2 t; t.x = __builtin_amdgcn_rcpf(d.x); t.y = __builtin_amdgcn_rcpf(d.y);
    f32x2 q = t * 0.5307027145f + (-0.7265760135f); q = q * t + 0.7107068705f; q = q * t + (-0.142248368f); q = q * t + 0.127414796f; q = q * t;
    const f32x2 s = (v * v) * (-0.72134752044f);
    f32x2 e; e.x = __builtin_amdgcn_exp2f(s.x); e.y = __builtin_amdgcn_exp2f(s.y);
    const f32x2 m = v * (q * e), r = v - m;
    f32x2 o; o.x = v.x < 0.f ? m.x : r.x; o.y = v.y < 0.f ? m.y : r.y; return o;
}
__device__ __forceinline__ f32x4 gelu4(f32x4 v) { f32x2 a = gelu_pk((f32x2){v[0], v[1]}), b = gelu_pk((f32x2){v[2], v[3]}); return (f32x4){a.x, a.y, b.x, b.y}; }
__device__ __forceinline__ float silu1(float v) { return v * __builtin_amdgcn_rcpf(1.0f + __builtin_amdgcn_exp2f(-1.4426950408889634f * v)); }
__device__ __forceinline__ f32x4 silu4(f32x4 v) { return (f32x4){silu1(v[0]), silu1(v[1]), silu1(v[2]), silu1(v[3])}; }
__device__ __forceinline__ u32x2 pk4(f32x4 v) { u32x2 w; w.x = cvt_pk_bf16(v[0], v[1]); w.y = cvt_pk_bf16(v[2], v[3]); return w; }
__device__ __forceinline__ void rope4(f32x4& v0, f32x4& v1, const float* cs) {
    const f32x4 a = *(const f32x4*)cs, b = *(const f32x4*)(cs + 4);
    const f32x4 co = {a[0], a[2], b[0], b[2]}, si = {a[1], a[3], b[1], b[3]};
    const f32x4 o0 = v0 * co - v1 * si, o1 = v0 * si + v1 * co; v0 = o0; v1 = o1;
}

struct EpiIn0 {
    static constexpr bool PERM = false, AFTER_DRAIN = false;
    bf16_t* P0; const float* rope0; float* vvp;
    __device__ __forceinline__ void operator()(const f32x4 (&acc)[2][2][4][2], const Unit& u, int wr, int wc, int fr, int fq) const {
        const int row0 = u.pm * BM + wr * 64 + fr, pn = u.pn, colw = pn * BM + wc * 32 + 4 * fq;
        const bool latent = u.pm * BM < LROWS;
        if (pn <= 2) {
#pragma unroll
            for (int ai = 0; ai < 2; ++ai)
#pragma unroll
                for (int m = 0; m < 4; ++m) { const int row = row0 + ai * HALF + m * 16; const float* cs = rope0 + ((size_t)(row % SEQ) * 32 + (wc & 1) * 16 + 4 * fq) * 2;
                    bf16_t* rp = P0 + (size_t)row * N_IN0 + colw;
#pragma unroll
                    for (int bj = 0; bj < 2; ++bj) { f32x4 v0 = acc[ai][bj][m][0], v1 = acc[ai][bj][m][1];
                        if (!(pn == 2 && bj == 1)) { if (latent) rope4(v0, v1, cs); if (pn < 2) { v0 = v0 * QSCALE0; v1 = v1 * QSCALE0; } }
                        *(u32x2*)(rp + bj * HALF) = pk4(v0); *(u32x2*)(rp + bj * HALF + 16) = pk4(v1); }
                    asm volatile("" ::: "memory"); }
        } else if (pn <= 6) {
#pragma unroll
            for (int ai = 0; ai < 2; ++ai)
#pragma unroll
                for (int m = 0; m < 4; ++m) { const int row = row0 + ai * HALF + m * 16; bf16_t* rp = P0 + (size_t)row * N_IN0 + colw; float s = 0.f, q = 0.f;
#pragma unroll
                    for (int bj = 0; bj < 2; ++bj) { const f32x4 v0 = gelu4(acc[ai][bj][m][0]), v1 = gelu4(acc[ai][bj][m][1]);
                        s += (v0[0] + v0[1]) + (v0[2] + v0[3]) + (v1[0] + v1[1]) + (v1[2] + v1[3]);
                        q += (v0[0] * v0[0] + v0[1] * v0[1]) + (v0[2] * v0[2] + v0[3] * v0[3]) + (v1[0] * v1[0] + v1[1] * v1[1]) + (v1[2] * v1[2] + v1[3] * v1[3]);
                        *(u32x2*)(rp + bj * HALF) = pk4(v0); *(u32x2*)(rp + bj * HALF + 16) = pk4(v1); }
                    if (pn >= 5) { s += __shfl_xor(s, 16); s += __shfl_xor(s, 32); q += __shfl_xor(q, 16); q += __shfl_xor(q, 32);
                        if (fq == 0) *(f32x2*)(vvp + ((size_t)row * 8 + (pn - 5) * 4 + wc) * 2) = (f32x2){s, q}; } }
        } else {
#pragma unroll
            for (int ai = 0; ai < 2; ++ai)
#pragma unroll
                for (int m = 0; m < 4; ++m) { const int row = row0 + ai * HALF + m * 16; bf16_t* rp = P0 + (size_t)row * N_IN0 + colw;
#pragma unroll
                    for (int bj = 0; bj < 2; ++bj) { *(u32x2*)(rp + bj * HALF) = pk4(silu4(acc[ai][bj][m][0])); *(u32x2*)(rp + bj * HALF + 16) = pk4(silu4(acc[ai][bj][m][1])); } }
        }
    }
};
struct EpiOut {
    static constexpr bool PERM = false, AFTER_DRAIN = false;
    const float* res; float* dst; const float* resc; float* dstc; const float* mod;
    __device__ __forceinline__ void operator()(const f32x4 (&acc)[2][2][4][2], const Unit& u, int wr, int wc, int fr, int fq) const {
        const bool latent = u.pm * BM < LROWS; const int rbase = latent ? u.pm * BM : u.pm * BM - LROWS; const int mr = latent ? (u.pm * BM) / SEQ : 8;
        const float* rs = latent ? res : resc; float* ds = latent ? dst : dstc;
        const int row0 = rbase + wr * 64 + fr, col0 = u.pn * BM + wc * 32 + 4 * fq;
        f32x4 g[2][2];
#pragma unroll
        for (int bj = 0; bj < 2; ++bj)
#pragma unroll
            for (int n = 0; n < 2; ++n) g[bj][n] = *(const f32x4*)(mod + (size_t)mr * 3072 + 2048 + col0 + bj * HALF + n * 16);
#pragma unroll
        for (int ai = 0; ai < 2; ++ai)
#pragma unroll
            for (int m = 0; m < 4; ++m) { const size_t off = (size_t)(row0 + ai * HALF + m * 16) * DM + col0;
#pragma unroll
                for (int bj = 0; bj < 2; ++bj)
#pragma unroll
                    for (int n = 0; n < 2; ++n) { const f32x4 b = *(const f32x4*)(rs + off + bj * HALF + n * 16); *(f32x4*)(ds + off + bj * HALF + n * 16) = b + g[bj][n] * acc[ai][bj][m][n]; }
                if (m & 1) asm volatile("" ::: "memory"); }
    }
};
struct EpiIn1 {
    static constexpr bool PERM = false, AFTER_DRAIN = false;
    bf16_t *QA, *KVA, *KPE, *G1; float *qsp, *kvsp; const float* rope1;
    __device__ __forceinline__ void operator()(const f32x4 (&acc)[2][2][4][2], const Unit& u, int wr, int wc, int fr, int fq) const {
        const int row0 = u.pm * BM + wr * 64 + fr, pn = u.pn, cw = wc * 32 + 4 * fq; const bool latent = u.pm * BM < LROWS;
#pragma unroll
        for (int ai = 0; ai < 2; ++ai)
#pragma unroll
            for (int m = 0; m < 4; ++m) { const int row = row0 + ai * HALF + m * 16;
                if (pn == 0) { float q = 0.f; bf16_t* rp = QA + (size_t)row * 256 + cw;
#pragma unroll
                    for (int bj = 0; bj < 2; ++bj) { const f32x4 v0 = acc[ai][bj][m][0], v1 = acc[ai][bj][m][1];
                        q += (v0[0] * v0[0] + v0[1] * v0[1]) + (v0[2] * v0[2] + v0[3] * v0[3]) + (v1[0] * v1[0] + v1[1] * v1[1]) + (v1[2] * v1[2] + v1[3] * v1[3]);
                        *(u32x2*)(rp + bj * HALF) = pk4(v0); *(u32x2*)(rp + bj * HALF + 16) = pk4(v1); }
                    q += __shfl_xor(q, 16); q += __shfl_xor(q, 32); if (fq == 0) qsp[(size_t)row * 4 + wc] = q;
                } else if (pn == 1) { bf16_t* rp = KVA + (size_t)row * 256 + cw;
                    { const f32x4 v0 = acc[ai][0][m][0], v1 = acc[ai][0][m][1];
                      float q = (v0[0] * v0[0] + v0[1] * v0[1]) + (v0[2] * v0[2] + v0[3] * v0[3]) + (v1[0] * v1[0] + v1[1] * v1[1]) + (v1[2] * v1[2] + v1[3] * v1[3]);
                      *(u32x2*)(rp) = pk4(v0); *(u32x2*)(rp + 16) = pk4(v1);
                      q += __shfl_xor(q, 16); q += __shfl_xor(q, 32); if (fq == 0) kvsp[(size_t)row * 4 + wc] = q; }
                    *(u32x2*)(rp + HALF) = (u32x2){0u, 0u}; *(u32x2*)(rp + HALF + 16) = (u32x2){0u, 0u};
                    if (wc == 0) { f32x4 v0 = acc[ai][1][m][0], v1 = acc[ai][1][m][1];
                        if (latent) rope4(v0, v1, rope1 + ((size_t)(row % SEQ) * 16 + 4 * fq) * 2);
                        bf16_t* kp = KPE + (size_t)row * 32 + 4 * fq; *(u32x2*)(kp) = pk4(v0); *(u32x2*)(kp + 16) = pk4(v1); }
                } else { bf16_t* rp = G1 + (size_t)row * DM + (pn - 2) * BM + cw;
#pragma unroll
                    for (int bj = 0; bj < 2; ++bj) { *(u32x2*)(rp + bj * HALF) = pk4(silu4(acc[ai][bj][m][0])); *(u32x2*)(rp + bj * HALF + 16) = pk4(silu4(acc[ai][bj][m][1])); } }
                asm volatile("" ::: "memory");
            }
    }
};
struct EpiQb {
    static constexpr bool PERM = false, AFTER_DRAIN = false;
    bf16_t* Q1; const float* qsp; const float* rope1;
    __device__ __forceinline__ void operator()(const f32x4 (&acc)[2][2][4][2], const Unit& u, int wr, int wc, int fr, int fq) const {
        const int row0 = u.pm * BM + wr * 64 + fr, colw = u.pn * BM + wc * 32 + 4 * fq;
#pragma unroll
        for (int ai = 0; ai < 2; ++ai)
#pragma unroll
            for (int m = 0; m < 4; ++m) { const int row = row0 + ai * HALF + m * 16; const f32x4 sp = *(const f32x4*)(qsp + (size_t)row * 4);
                const float sc = QSCALE1 * __builtin_amdgcn_rsqf(((sp[0] + sp[1]) + (sp[2] + sp[3])) * (1.0f / 256) + NORM_EPS);
                bf16_t* rp = Q1 + (size_t)row * 1536 + colw;
#pragma unroll
                for (int bj = 0; bj < 2; ++bj) { f32x4 v0 = acc[ai][bj][m][0] * sc, v1 = acc[ai][bj][m][1] * sc; const int g32 = u.pn * 8 + bj * 4 + wc;
                    if (g32 % 3 == 2) rope4(v0, v1, rope1 + ((size_t)(row % SEQ) * 16 + 4 * fq) * 2);
                    *(u32x2*)(rp + bj * HALF) = pk4(v0); *(u32x2*)(rp + bj * HALF + 16) = pk4(v1); }
                asm volatile("" ::: "memory"); }
    }
};
struct EpiKvb {
    static constexpr bool PERM = false, AFTER_DRAIN = false;
    bf16_t *K1N, *V1; const float* kvsp;
    __device__ __forceinline__ void operator()(const f32x4 (&acc)[2][2][4][2], const Unit& u, int wr, int wc, int fr, int fq) const {
        const int row0 = u.pm * BM + wr * 64 + fr, colw = (u.pn & 3) * BM + wc * 32 + 4 * fq; bf16_t* dst = u.pn < 4 ? K1N : V1;
#pragma unroll
        for (int ai = 0; ai < 2; ++ai)
#pragma unroll
            for (int m = 0; m < 4; ++m) { const int row = row0 + ai * HALF + m * 16; const f32x4 sp = *(const f32x4*)(kvsp + (size_t)row * 4);
                const float sc = __builtin_amdgcn_rsqf(((sp[0] + sp[1]) + (sp[2] + sp[3])) * (1.0f / 128) + NORM_EPS);
                bf16_t* rp = dst + (size_t)row * DM + colw;
#pragma unroll
                for (int bj = 0; bj < 2; ++bj) { *(u32x2*)(rp + bj * HALF) = pk4(acc[ai][bj][m][0] * sc); *(u32x2*)(rp + bj * HALF + 16) = pk4(acc[ai][bj][m][1] * sc); }
                asm volatile("" ::: "memory"); }
    }
};
}
namespace att {
using bf16x8 = __attribute__((ext_vector_type(8))) short;
using s16x4 = __attribute__((ext_vector_type(4))) short;
using f32x16 = __attribute__((ext_vector_type(16))) float;
using u32x4 = __attribute__((ext_vector_type(4))) unsigned;
typedef short v4i16_t __attribute__((ext_vector_type(4)));
typedef float f32x2_t __attribute__((ext_vector_type(2))); typedef __bf16 bf16x2_t __attribute__((ext_vector_type(2)));
constexpr int NW = 8, QBLK = 32, QB = 256, KVBLK = 64, NSLOT = 3;
constexpr int KSLOT = 12288, VSLOT = 8192;
constexpr int LDS_K = 0, LDS_V = NSLOT * KSLOT, LDS_WS = LDS_V + NSLOT * VSLOT, LDS_OST = LDS_WS + NW * 64 * 4, LDS_BYTES = LDS_OST + NW * 4096;
constexpr float THR = 6.0f;
__device__ __forceinline__ int crow(int r, int hi) { return (r & 3) + 8 * (r >> 2) + 4 * hi; }
__device__ __forceinline__ void glds16(const void* gsrc, unsigned lds_dst) { unsigned keep;
    asm volatile("s_mov_b32 %0, m0\n\ts_mov_b32 m0, %2\n\ts_nop 0\n\tglobal_load_lds_dwordx4 %1, off\n\ts_mov_b32 m0, %0" : "=&s"(keep) : "v"(gsrc), "s"(lds_dst) : "memory"); }
__device__ __forceinline__ unsigned cvtpk(float lo, float hi) { f32x2_t v = {lo, hi}; bf16x2_t b = __builtin_convertvector(v, bf16x2_t); return __builtin_bit_cast(unsigned, b); }
#define ATT_WAIT_BAR(N) asm volatile("s_waitcnt vmcnt(" #N ") lgkmcnt(0)\n\ts_barrier" ::: "memory")
#define ATT_SBAR() __builtin_amdgcn_sched_barrier(0)

struct Desc {
    const bf16_t* Q; int qpitch;
    const bf16_t* K; int kpitch;
    const bf16_t* K2; int k2pitch;
    const bf16_t* V; int vpitch;
    const bf16_t* G; int gpitch;
    bf16_t* O; int opitch;
    long qrow0;
    long lat_row0; int ntl;
    long ctx_row0; int ntc;
    int band_q0, band_k0;
    float sink; int has_sink;
};

template <int ND0, bool WINDOWED>
__device__ __forceinline__ void unit(const Desc& D, char* shm) {
    constexpr int NCH = 2 * ND0;
    int tid_ = tid_rebuilt(); asm volatile("" : "+v"(tid_));
    const int tid = tid_, lane = tid & 63, r32 = lane & 31, hi = lane >> 5; const int wid = __builtin_amdgcn_readfirstlane(tid >> 6);
    const unsigned lds0 = (unsigned)(uintptr_t)shm;
    float* wsf = (float*)(shm + LDS_WS) + wid * 64;
    const int NT = D.ntl + D.ntc;
    const int ch2 = 8 + (wid & 3);
    const unsigned kdst = lds0 + LDS_K + wid * 1024, kdst2 = lds0 + LDS_K + ch2 * 1024, vdst = lds0 + LDS_V + wid * 1024;
    const int vr = 16 * (wid & 3) + (lane >> 2), vc = (wid >> 2) * 32 + (lane & 3) * 8;
#define ATT_KROW0(t) ((t) < D.ntl ? D.lat_row0 + (long)(t) * KVBLK : D.ctx_row0 + (long)((t) - D.ntl) * KVBLK)
#define ATT_DMA(t, slot) do { const long kr0_ = ATT_KROW0(t); \
        glds16(D.K + (kr0_ + lane) * D.kpitch + wid * 8, (unsigned)__builtin_amdgcn_readfirstlane(kdst + (slot) * KSLOT)); \
        if (NCH > 8 && wid < 4) glds16(D.K2 + (kr0_ + lane) * D.k2pitch + (ch2 - 8) * 8, (unsigned)__builtin_amdgcn_readfirstlane(kdst2 + (slot) * KSLOT)); \
        glds16(D.V + (kr0_ + vr) * D.vpitch + vc, (unsigned)__builtin_amdgcn_readfirstlane(vdst + (slot) * VSLOT)); } while (0)
#define ATT_WAIT_TILE(ahead) do { if (NCH > 8 && wid < 4) { if ((ahead) == 2) ATT_WAIT_BAR(6); else if ((ahead) == 1) ATT_WAIT_BAR(3); else ATT_WAIT_BAR(0); } \
        else { if ((ahead) == 2) ATT_WAIT_BAR(4); else if ((ahead) == 1) ATT_WAIT_BAR(2); else ATT_WAIT_BAR(0); } } while (0)
    ATT_DMA(0, 0);
    if (NT > 1) ATT_DMA(1, 1);
    const bf16_t* Qw = D.Q + (D.qrow0 + wid * QBLK + r32) * D.qpitch;
    bf16x8 qr[ND0];
#pragma unroll
    for (int d0 = 0; d0 < ND0; ++d0) qr[d0] = *reinterpret_cast<const bf16x8*>(Qw + d0 * 16 + hi * 8);
    float mhat = -1e4f, l_reg = 0.f; f32x16 o[2];
    o[0] = f32x16{}; o[1] = f32x16{};
    const int qidx = D.band_q0 + wid * QBLK;
    const int vb0 = (int)(lds0 + LDS_V) + ((lane >> 4) & 1) * 32 + (lane & 3) * 8 + (4 * hi + ((lane & 15) >> 2)) * 64;
    int slot = 0;
    for (int t = 0; t < NT; ++t) {
        if (t + 1 < NT) { ATT_WAIT_TILE(1); } else { ATT_WAIT_TILE(0); }
        if (t + 2 < NT) { const int s2 = slot + 2 >= NSLOT ? slot + 2 - NSLOT : slot + 2; ATT_DMA(t + 2, s2); }
        bool skip = false, domask = false; int jt = 0;
        if (WINDOWED && t < D.ntl) { jt = D.band_k0 + t * KVBLK;
            skip = (jt - (qidx + 31) > 128) || (qidx - (jt + 63) > 128);
            domask = !((jt + 63 - qidx <= 128) && (qidx + 31 - jt <= 128)); }
        if (!skip) {
            const char* kb = shm + LDS_K + slot * KSLOT + hi * 1024 + r32 * 16;
            f32x16 p0 = f32x16{}, p1 = f32x16{};
#pragma unroll
            for (int d0 = 0; d0 < ND0; ++d0) {
                const bf16x8 b0 = *reinterpret_cast<const bf16x8*>(kb + d0 * 2048);
                const bf16x8 b1 = *reinterpret_cast<const bf16x8*>(kb + d0 * 2048 + 512);
                p0 = __builtin_amdgcn_mfma_f32_32x32x16_bf16(b0, qr[d0], p0, 0, 0, 0);
                p1 = __builtin_amdgcn_mfma_f32_32x32x16_bf16(b1, qr[d0], p1, 0, 0, 0);
            }
            if (WINDOWED && domask) { const int qi = qidx + r32;
#pragma unroll
                for (int r = 0; r < 16; ++r) { const int j = jt + crow(r, hi); const int d0_ = j - qi, d1_ = d0_ + 32;
                    if (d0_ > 128 || d0_ < -128) p0[r] = -1e30f; if (d1_ > 128 || d1_ < -128) p1[r] = -1e30f; } }
            float rm = fmaxf(p0[0], p1[0]);
#pragma unroll
            for (int r = 1; r < 16; ++r) rm = fmaxf(rm, fmaxf(p0[r], p1[r]));
            rm -= mhat;
            { auto rr = __builtin_amdgcn_permlane32_swap(__float_as_uint(rm), __float_as_uint(rm), false, false); rm = fmaxf(__uint_as_float(rr[0]), __uint_as_float(rr[1])); }
            if (__any(rm > THR)) {
                const float dl = fmaxf(rm, 0.f); mhat += dl; const float f = __builtin_amdgcn_exp2f(-dl); l_reg *= f;
                if (hi == 0) wsf[r32] = f;
                asm volatile("s_waitcnt lgkmcnt(0)" ::: "memory");
#pragma unroll
                for (int r = 0; r < 16; ++r) { const float fr_ = wsf[crow(r, hi)]; o[0][r] *= fr_; o[1][r] *= fr_; }
            }
            float sacc = 0.f;
#pragma unroll
            for (int r = 0; r < 16; ++r) { p0[r] = __builtin_amdgcn_exp2f(p0[r] - mhat); p1[r] = __builtin_amdgcn_exp2f(p1[r] - mhat); sacc += p0[r] + p1[r]; }
            l_reg += sacc;
            u32x4 pw0 = {cvtpk(p0[0], p0[1]), cvtpk(p0[2], p0[3]), cvtpk(p0[4], p0[5]), cvtpk(p0[6], p0[7])};
            u32x4 pw1 = {cvtpk(p0[8], p0[9]), cvtpk(p0[10], p0[11]), cvtpk(p0[12], p0[13]), cvtpk(p0[14], p0[15])};
            u32x4 pw2 = {cvtpk(p1[0], p1[1]), cvtpk(p1[2], p1[3]), cvtpk(p1[4], p1[5]), cvtpk(p1[6], p1[7])};
            u32x4 pw3 = {cvtpk(p1[8], p1[9]), cvtpk(p1[10], p1[11]), cvtpk(p1[12], p1[13]), cvtpk(p1[14], p1[15])};
            const bf16x8 pa[4] = {__builtin_bit_cast(bf16x8, pw0), __builtin_bit_cast(bf16x8, pw1), __builtin_bit_cast(bf16x8, pw2), __builtin_bit_cast(bf16x8, pw3)};
            const int vb = vb0 + slot * VSLOT;
#pragma unroll
            for (int d0 = 0; d0 < 2; ++d0) { s16x4 lo[4], hh[4];
#pragma unroll
                for (int ks = 0; ks < 4; ++ks) {
                    asm volatile("ds_read_b64_tr_b16 %0,%1 offset:%c2" : "=&v"(lo[ks]) : "v"(vb), "i"(d0 * 4096 + ks * 1024) : "memory");
                    asm volatile("ds_read_b64_tr_b16 %0,%1 offset:%c2" : "=&v"(hh[ks]) : "v"(vb), "i"(d0 * 4096 + ks * 1024 + 512) : "memory"); }
                asm volatile("s_waitcnt lgkmcnt(0)" ::: "memory"); ATT_SBAR();
#pragma unroll
                for (int ks = 0; ks < 4; ++ks) { const bf16x8 vf = {lo[ks][0], lo[ks][1], lo[ks][2], lo[ks][3], hh[ks][0], hh[ks][1], hh[ks][2], hh[ks][3]};
                    o[d0] = __builtin_amdgcn_mfma_f32_32x32x16_bf16(pa[ks], vf, o[d0], 0, 0, 0); }
            }
        }
        slot = slot + 1 >= NSLOT ? 0 : slot + 1;
    }
    { auto rr = __builtin_amdgcn_permlane32_swap(__float_as_uint(l_reg), __float_as_uint(l_reg), false, false); l_reg = __uint_as_float(rr[0]) + __uint_as_float(rr[1]); }
    if (D.has_sink) l_reg += __builtin_amdgcn_exp2f(D.sink - mhat);
    if (hi == 0) wsf[32 + r32] = l_reg;
    asm volatile("s_waitcnt lgkmcnt(0)" ::: "memory");
    float rli[16];
#pragma unroll
    for (int r = 0; r < 16; ++r) rli[r] = __builtin_amdgcn_rcpf(wsf[32 + crow(r, hi)]);
    { __hip_bfloat16* stg = (__hip_bfloat16*)(shm + LDS_OST) + wid * 2048;
#pragma unroll
      for (int r = 0; r < 16; ++r) { const int orow = crow(r, hi);
#pragma unroll
          for (int d0 = 0; d0 < 2; ++d0) stg[orow * 64 + d0 * 32 + r32] = __float2bfloat16(o[d0][r] * rli[r]); }
      asm volatile("s_waitcnt lgkmcnt(0)" ::: "memory");
#pragma unroll
      for (int i = 0; i < 4; ++i) { const int row = i * 8 + (lane >> 3), c8 = (lane & 7) * 8; const long grow = D.qrow0 + wid * QBLK + row;
          const u32x4 ov = *(const u32x4*)(stg + row * 64 + c8); const u32x4 gv = *(const u32x4*)(D.G + grow * D.gpitch + c8); u32x4 w;
#pragma unroll
          for (int k = 0; k < 4; ++k) { const float a0 = __uint_as_float(ov[k] << 16) * __uint_as_float(gv[k] << 16), a1 = __uint_as_float(ov[k] & 0xffff0000u) * __uint_as_float(gv[k] & 0xffff0000u); w[k] = cvtpk(a0, a1); }
          *(u32x4*)(D.O + grow * D.opitch + c8) = w; } }
    asm volatile("s_waitcnt vmcnt(0) lgkmcnt(0)\n\ts_barrier" ::: "memory");
#undef ATT_KROW0
#undef ATT_DMA
#undef ATT_WAIT_TILE
}
}
namespace thin {
#define TH_LAS __attribute__((address_space(3)))
typedef float f32x4 __attribute__((ext_vector_type(4)));
typedef float f32x2 __attribute__((ext_vector_type(2)));
typedef float f32x16 __attribute__((ext_vector_type(16)));
typedef unsigned u32x4 __attribute__((ext_vector_type(4)));
typedef unsigned u32x2 __attribute__((ext_vector_type(2)));
typedef short bf16x8 __attribute__((ext_vector_type(8)));
__device__ __forceinline__ unsigned pk2(float lo, float hi) { return (unsigned)f2bf(lo) | ((unsigned)f2bf(hi) << 16); }
__device__ __forceinline__ float wave_sum(float v) {
#pragma unroll
    for (int o = 1; o < 64; o <<= 1) v += __shfl_xor(v, o);
    return v;
}
struct MapId { __device__ __forceinline__ int operator()(int n) const { return n; } };
struct MapIn1 { __device__ __forceinline__ int operator()(int n) const { return n < 384 ? n : (n < 416 ? 384 + pe_orig(n - 384) : (n < 512 ? -1 : n - 96)); } };
struct MapQb { __device__ __forceinline__ int operator()(int n) const { const int h = n / 96, w = n % 96; return h * 96 + (w < 64 ? w : 64 + pe_orig(w - 64)); } };
struct MapKvb { __device__ __forceinline__ int operator()(int n) const { const int nn = n & 1023; return (nn >> 6) * 128 + (nn & 63) + (n >= 1024 ? 64 : 0); } };
template <class MAP>
__device__ __forceinline__ void wcopy_item(const float* W, int Ksrc, int ldw, bf16_t* WT, int ldt, const float* scale, TH_LAS float* scr, int item, int nblk, int lane, MAP map) {
    const int kb = item / nblk, nb = item % nblk, k0 = 64 * kb, n0 = 32 * nb;
    const int sc = map(n0 + (lane & 31));
#pragma unroll 8
    for (int i = 0; i < 32; ++i) { const int kk = 2 * i + (lane >> 5); float v = 0.f;
        if (sc >= 0 && k0 + kk < Ksrc) { v = W[(size_t)(k0 + kk) * ldw + sc]; if (scale) v *= scale[k0 + kk]; }
        scr[kk * 33 + (lane & 31)] = v; }
    asm volatile("s_waitcnt lgkmcnt(0)" ::: "memory");
    const int c = lane & 7;
#pragma unroll
    for (int j = 0; j < 4; ++j) { const int n = (lane >> 3) + 8 * j; const TH_LAS float* s = scr + (8 * c) * 33 + n;
        u32x4 o; o.x = pk2(s[0 * 33], s[1 * 33]); o.y = pk2(s[2 * 33], s[3 * 33]); o.z = pk2(s[4 * 33], s[5 * 33]); o.w = pk2(s[6 * 33], s[7 * 33]);
        *(u32x4*)(WT + (size_t)(n0 + n) * ldt + k0 + 8 * c) = o; }
    asm volatile("s_waitcnt lgkmcnt(0)" ::: "memory");
}
constexpr int WI_IN0 = 16 * 88, WI_OUT0 = 16 * 32, WI_IN1 = 16 * 48, WI_QB = 4 * 48, WI_KVB = 4 * 64, WI_OUT1 = 16 * 32, WI_WS = 64  ;
constexpr int WI_ROPE = (SEQ * 48 + 63) / 64, WI_ADA = 2 * 12 * 32;
constexpr int WI_TOTAL = WI_IN0 + WI_OUT0 + WI_IN1 + WI_QB + WI_KVB + WI_OUT1 + WI_WS + WI_ROPE + WI_ADA;
__device__ __forceinline__ void stage0_item(const Params& p, int it, TH_LAS float* scr, int lane) {
    if (it < WI_ADA) {
        const int l = it / (12 * 32), nb = (it / 32) % 12, ks = it % 32, n = nb * 256 + lane * 4;
        f32x4 acc[9];
#pragma unroll
        for (int r = 0; r < 9; ++r) acc[r] = (f32x4){0.f, 0.f, 0.f, 0.f};
        const float* w = p.w_ada + (size_t)l * DM * 3072 + n;
#pragma unroll 4
        for (int k = ks * 32; k < ks * 32 + 32; ++k) { const f32x4 wv = *(const f32x4*)(w + (size_t)k * 3072);
#pragma unroll
            for (int r = 0; r < 9; ++r) { const float cv = r < 8 ? p.c[r * DM + k] : p.c_ctx[k]; acc[r] += wv * (cv * __builtin_amdgcn_rcpf(1.0f + __expf(-cv))); } }
        if (ks == 0) { const f32x4 bb = *(const f32x4*)(p.b_ada + l * 3072 + n);
#pragma unroll
            for (int r = 0; r < 9; ++r) acc[r] += bb; }
        float* md = WSP(float, WS_MOD) + (size_t)l * 9 * 3072 + n;
#pragma unroll
        for (int r = 0; r < 9; ++r)
#pragma unroll
            for (int i = 0; i < 4; ++i) atomicAdd(md + (size_t)r * 3072 + i, acc[r][i]);
        return; } it -= WI_ADA;
    if (it < WI_IN0) { wcopy_item(p.w_in0, DM, N_IN0, WSP(bf16_t, WS_WIN0), DM, nullptr, scr, it, 88, lane, MapId()); return; } it -= WI_IN0;
    if (it < WI_OUT0) { wcopy_item(p.w_out0, DM, DM, WSP(bf16_t, WS_WOUT0), DM, nullptr, scr, it, 32, lane, MapId()); return; } it -= WI_OUT0;
    if (it < WI_IN1) { wcopy_item(p.w_in1, DM, 1440, WSP(bf16_t, WS_WIN1), DM, nullptr, scr, it, 48, lane, MapIn1()); return; } it -= WI_IN1;
    if (it < WI_QB) { wcopy_item(p.w_qb, 256, 1536, WSP(bf16_t, WS_WQB), 256, p.q_norm, scr, it, 48, lane, MapQb()); return; } it -= WI_QB;
    if (it < WI_KVB) { wcopy_item(p.w_kvb, 128, 2048, WSP(bf16_t, WS_WKVB), 256, p.kv_norm, scr, it, 64, lane, MapKvb()); return; } it -= WI_KVB;
    if (it < WI_OUT1) { wcopy_item(p.w_out1, DM, DM, WSP(bf16_t, WS_WOUT1), DM, nullptr, scr, it, 32, lane, MapId()); return; } it -= WI_OUT1;
    if (it < WI_WS) { const size_t base = (size_t)it * 2048 + lane * 4;
#pragma unroll
        for (int j = 0; j < 8; ++j) { const f32x4 v = *(const f32x4*)(p.gm_ws + base + j * 256); *(u32x2*)(WSP(bf16_t, WS_WS) + base + j * 256) = (u32x2){pk2(v[0], v[1]), pk2(v[2], v[3])}; }
        return; } it -= WI_WS;
    { const long e = (long)it * 64 + lane; if (e < ROPE_ITEMS) nk_rope(p, e); }
}
__device__ __forceinline__ void modnorm_row(const Params& p, long r, int layer, int lane) {
    const float* src; int mr;
    if (r < LROWS) { src = (layer == 0 ? p.x : p.out) + (size_t)r * DM; mr = (int)(r / SEQ); }
    else { src = (layer == 0 ? p.ctx : WSP(float, WS_X1C)) + (size_t)(r - LROWS) * DM; mr = 8; }
    const f32x4* xr = (const f32x4*)src + lane; f32x4 v[4]; float s = 0.f;
#pragma unroll
    for (int j = 0; j < 4; ++j) { v[j] = xr[64 * j]; s += (v[j][0] * v[j][0] + v[j][1] * v[j][1]) + (v[j][2] * v[j][2] + v[j][3] * v[j][3]); }
    const float rstd = 1.0f / sqrtf(wave_sum(s) * (1.0f / DM) + NORM_EPS);
    const f32x4* md = (const f32x4*)(WSP(float, WS_MOD) + ((size_t)layer * 9 + mr) * 3072) + lane; const f32x4* g = (const f32x4*)(p.norm_g + layer * DM) + lane;
    u32x2* o = (u32x2*)(WSP(bf16_t, WS_H) + (size_t)r * DM) + lane;
#pragma unroll
    for (int j = 0; j < 4; ++j) { const f32x4 sh = md[64 * j], sc = md[256 + 64 * j], gg = g[64 * j]; const f32x4 y = v[j] * rstd * gg * (sc + 1.0f) + sh; o[64 * j] = (u32x2){pk2(y[0], y[1]), pk2(y[2], y[3])}; }
}
__device__ __forceinline__ void final_row(const Params& p, long r, int lane) {
    f32x4* xr = (f32x4*)(p.out + (size_t)r * DM) + lane; f32x4 v[4]; float s = 0.f;
#pragma unroll
    for (int j = 0; j < 4; ++j) { v[j] = xr[64 * j]; s += (v[j][0] * v[j][0] + v[j][1] * v[j][1]) + (v[j][2] * v[j][2] + v[j][3] * v[j][3]); }
    const float rstd = 1.0f / sqrtf(wave_sum(s) * (1.0f / DM) + NORM_EPS); const f32x4* g = (const f32x4*)p.final_g + lane;
#pragma unroll
    for (int j = 0; j < 4; ++j) xr[64 * j] = v[j] * rstd * g[64 * j];
}
constexpr int GM_PITCH = 136;
constexpr int GM_LDS = 64 * GM_PITCH * 2;
__device__ __forceinline__ void gmlp_unit(const Params& p, long r0, int g, char* shm) {
    int tid_ = tid_rebuilt(); asm volatile("" : "+v"(tid_));
    const int tid = tid_, lane = tid & 63, r32 = lane & 31, hi = lane >> 5; const int wid = __builtin_amdgcn_readfirstlane(tid >> 6);
    const bf16_t* P0 = WSP(bf16_t, WS_P0); bf16_t* vnT = (bf16_t*)shm;
#pragma unroll
    for (int rep = 0; rep < 2; ++rep) { const int item = tid + rep * 512, q = item >> 3, c8 = item & 7;
        const f32x4* pt = (const f32x4*)(WSP(float, WS_VVP) + (size_t)(r0 + q) * 16); const f32x4 a = pt[0], b = pt[1], c = pt[2], d = pt[3];
        const float sm = (a[0] + a[2]) + (b[0] + b[2]) + (c[0] + c[2]) + (d[0] + d[2]), sq = (a[1] + a[3]) + (b[1] + b[3]) + (c[1] + c[3]) + (d[1] + d[3]);
        const float mean = sm * (1.0f / 512), rstd = __builtin_amdgcn_rsqf(sq * (1.0f / 512) - mean * mean + NORM_EPS);
        const u32x4 raw = *(const u32x4*)(P0 + (size_t)(r0 + q) * N_IN0 + C_VV + 64 * g + 8 * c8);
        const f32x4 g0 = *(const f32x4*)(p.gm_ln_g + 64 * g + 8 * c8), g1 = *(const f32x4*)(p.gm_ln_g + 64 * g + 8 * c8 + 4);
        const f32x4 b0 = *(const f32x4*)(p.gm_ln_b + 64 * g + 8 * c8), b1 = *(const f32x4*)(p.gm_ln_b + 64 * g + 8 * c8 + 4);
#pragma unroll
        for (int k = 0; k < 4; ++k) { const float x0 = __uint_as_float(raw[k] << 16), x1 = __uint_as_float(raw[k] & 0xffff0000u);
            const float gg0 = k < 2 ? g0[2 * k] : g1[2 * k - 4], gg1 = k < 2 ? g0[2 * k + 1] : g1[2 * k - 3], bb0 = k < 2 ? b0[2 * k] : b1[2 * k - 4], bb1 = k < 2 ? b0[2 * k + 1] : b1[2 * k - 3];
            vnT[(8 * c8 + 2 * k) * GM_PITCH + q] = f2bf((x0 - mean) * rstd * gg0 + bb0); vnT[(8 * c8 + 2 * k + 1) * GM_PITCH + q] = f2bf((x1 - mean) * rstd * gg1 + bb1); } }
    __syncthreads();
    const int pb = wid & 3, cbk = wid >> 2;
    const bf16_t* wr_ = WSP(bf16_t, WS_WS) + ((size_t)g * 128 + 32 * pb + r32) * 128 + 8 * hi; const bf16_t* ar_ = vnT + (32 * cbk + r32) * GM_PITCH + 8 * hi;
    f32x16 acc = f32x16{};
#pragma unroll
    for (int ks = 0; ks < 8; ++ks) { const bf16x8 af = *(const bf16x8*)(ar_ + 16 * ks), bf = *(const bf16x8*)(wr_ + 16 * ks); acc = __builtin_amdgcn_mfma_f32_32x32x16_bf16(af, bf, acc, 0, 0, 0); }
    const long row = r0 + 32 * pb + r32; const float bs = p.gm_bs[g * 128 + 32 * pb + r32];
    const bf16_t* prow = P0 + (size_t)row * N_IN0; bf16_t* orow = WSP(bf16_t, WS_MIX) + (size_t)row * DM + 512;
#pragma unroll
    for (int g4 = 0; g4 < 4; ++g4) { const int cc = 64 * g + 32 * cbk + 8 * g4 + 4 * hi;
        const u32x2 uu = *(const u32x2*)(prow + C_U + cc), gt = *(const u32x2*)(prow + C_G + 512 + cc); u32x2 w;
#pragma unroll
        for (int k = 0; k < 2; ++k) { const float u0 = __uint_as_float(uu[k] << 16), u1 = __uint_as_float(uu[k] & 0xffff0000u), t0 = __uint_as_float(gt[k] << 16), t1 = __uint_as_float(gt[k] & 0xffff0000u);
            w[k] = pk2(u0 * (acc[4 * g4 + 2 * k] + bs) * t0, u1 * (acc[4 * g4 + 2 * k + 1] + bs) * t1); }
        *(u32x2*)(orow + cc) = w; }
    __syncthreads();
}
}
#define LAS __attribute__((address_space(3)))
#define XB_TMO      128
#define XB_XCNT(j)  (256  + 64 * (j))
#define XB_XSUB(j)  (1280 + 64 * (j))
#define XB_XGEN(j)  (2304 + 64 * (j))
#define XB_TOP      3328
#define XB_TOPGEN   3392
#define XCD_BAR_WORDS 3456
#define XB_SPIN_CAP (1u << 18)

__device__ __forceinline__ unsigned xb_ld(unsigned* p)              { return __hip_atomic_load(p, __ATOMIC_RELAXED, __HIP_MEMORY_SCOPE_AGENT); }
__device__ __forceinline__ unsigned xb_add(unsigned* p, unsigned v) { return __hip_atomic_fetch_add(p, v, __ATOMIC_RELAXED, __HIP_MEMORY_SCOPE_AGENT); }
__device__ __forceinline__ unsigned xb_xcc_id() { return (unsigned)__builtin_amdgcn_s_getreg((3 << 11) | 20) & 0xFu; }
#define XB_SPIN(cond, bar) do { unsigned _sp = 0; while (cond) { __builtin_amdgcn_s_sleep(1); \
    if ((++_sp & 255u) == 0u) { if (xb_ld(&(bar)[XB_TMO])) break; if (_sp > XB_SPIN_CAP) { atomicAdd(&(bar)[XB_TMO], 1u); break; } } } } while (0)

struct XcdBarrier {
    unsigned* bar; unsigned x;
    volatile LAS unsigned* st;
};

__device__ __forceinline__ XcdBarrier xcd_barrier_post(unsigned* bar, volatile LAS unsigned* st) {
    XcdBarrier b; b.bar = bar; b.x = xb_xcc_id(); b.st = st;
    if (threadIdx.x == 0) (void)xb_add(&bar[XB_XCNT(b.x)], 1u);
    return b;
}
__device__ __forceinline__ void xcd_barrier_complete(unsigned* bar, unsigned x, unsigned& nloc, unsigned& nx) {
    const unsigned G = gridDim.x * gridDim.y * gridDim.z;
    unsigned sum, cnt, mine, sp = 0u;
    for (;;) {
        sum = 0u; cnt = 0u; mine = 0u;
#pragma unroll
        for (unsigned j = 0; j < 16; ++j) { const unsigned c = xb_ld(&bar[XB_XCNT(j)]); sum += c; cnt += (c > 0u) ? 1u : 0u; mine = (j == x) ? c : mine; }
        if (sum == G) break;
        __builtin_amdgcn_s_sleep(1);
        if ((++sp & 255u) == 0u) { if (xb_ld(&bar[XB_TMO])) break; if (sp > XB_SPIN_CAP) { atomicAdd(&bar[XB_TMO], 1u); break; } }
    }
    nloc = mine > 0u ? mine : 1u; nx = cnt > 0u ? cnt : 1u;
}

__device__ __forceinline__ void xcd_barrier(const XcdBarrier& b, bool leader_thread) {
    asm volatile("s_waitcnt vmcnt(0)" ::: "memory");
    __syncthreads();
    if (leader_thread) {
        unsigned* bar = b.bar;
        __builtin_amdgcn_s_waitcnt(0);
        unsigned nloc = b.st[0], nx = b.st[1];
        if (nloc == 0u) { xcd_barrier_complete(bar, b.x, nloc, nx); b.st[0] = nloc; b.st[1] = nx; }
        const unsigned old = xb_add(&bar[XB_XSUB(b.x)], 1u);
        const unsigned gen = old / nloc;
        if (old + 1u == (gen + 1u) * nloc) {
            __builtin_amdgcn_fence(__ATOMIC_RELEASE, "agent");
            asm volatile("s_waitcnt vmcnt(0)" ::: "memory");
            const unsigned og = xb_add(&bar[XB_TOP], 1u);
            const unsigned tg = og / nx;
            if (og + 1u == (tg + 1u) * nx) xb_add(&bar[XB_TOPGEN], 1u);
            else XB_SPIN(xb_ld(&bar[XB_TOPGEN]) == tg, bar);
            __builtin_amdgcn_fence(__ATOMIC_ACQUIRE, "agent");
            xb_add(&bar[XB_XGEN(b.x)], 1u);
            asm volatile("s_waitcnt vmcnt(0)" ::: "memory");
        } else {
            XB_SPIN(xb_ld(&bar[XB_XGEN(b.x)]) == gen, bar);
            __builtin_amdgcn_fence(__ATOMIC_ACQUIRE, "agent");
            asm volatile("s_waitcnt vmcnt(0)" ::: "memory");
        }
    }
    __syncthreads();
}
namespace cg = cooperative_groups;
constexpr int NTHREADS = 512, NWAVES = 8;
constexpr int LDS_BYTES = 147456;
static_assert(att::LDS_BYTES <= 131072 && thin::GM_LDS <= 131072 && NWAVES * 64 * 33 * 4 <= 131072, "LDS map");
#ifndef GSEL_IN0
#define GSEL_IN0 1
#endif
#ifndef GSEL_OUT0
#define GSEL_OUT0 1
#endif
#ifndef GSEL_IN1
#define GSEL_IN1 1
#endif
#ifndef GSEL_QB
#define GSEL_QB 1
#endif
#ifndef GSEL_KVB
#define GSEL_KVB 1
#endif
#ifndef GSEL_OUT1
#define GSEL_OUT1 1
#endif
#ifndef REP_NORM0
#define REP_NORM0 1
#endif
#ifndef REP_IN0
#define REP_IN0 1
#endif
#ifndef REP_ATT0
#define REP_ATT0 1
#endif
#ifndef REP_GMLP
#define REP_GMLP 1
#endif
#ifndef REP_OUT0
#define REP_OUT0 1
#endif
#ifndef REP_NORM1
#define REP_NORM1 1
#endif
#ifndef REP_IN1
#define REP_IN1 1
#endif
#ifndef REP_QB
#define REP_QB 1
#endif
#ifndef REP_KVB
#define REP_KVB 1
#endif
#ifndef REP_ATT1
#define REP_ATT1 1
#endif
#ifndef REP_SYNC
#define REP_SYNC 1
#endif
#ifndef PG8_SP2
#define PG8_SP2 true
#endif
#ifndef PG8_ALIGN
#define PG8_ALIGN true
#endif
#ifndef OPT_S0
#define OPT_S0 1
#endif
#ifndef OPT_NORM
#define OPT_NORM 1
#endif
#ifndef OPT_GEMM
#define OPT_GEMM 1
#endif
#ifndef OPT_ATT0
#define OPT_ATT0 1
#endif
#ifndef OPT_GMLP
#define OPT_GMLP 1
#endif
#ifndef OPT_ATT1
#define OPT_ATT1 1
#endif

template <int S> __device__ __forceinline__ void naive_stage(const Params& p) {
    const long n = stage_items(S);
    for (long it = (long)blockIdx.x * NTHREADS + threadIdx.x; it < n; it += (long)gridDim.x * NTHREADS) stage_item(p, S, it);
}
#define GRID_SYNC() do { for (int rs_ = 0; rs_ < REP_SYNC; ++rs_) xcd_barrier(bar, wid == 0 && lane_id() == 0); } while (0)
#define GRID_SYNC_CG() grid.sync()

__device__ __forceinline__ Params load_params() {
    Params r{};
#if defined(__HIP_DEVICE_COMPILE__)
    typedef const __attribute__((address_space(4))) unsigned long long* KP64;
    KP64 kp = (KP64)__builtin_amdgcn_kernarg_segment_ptr(); asm volatile("" : "+s"(kp));
    unsigned long long w[23];
#pragma unroll
    for (int i = 0; i < 23; ++i) w[i] = kp[i];
    r.x = (const float*)w[0]; r.c = (const float*)w[1]; r.ctx = (const float*)w[2]; r.c_ctx = (const float*)w[3]; r.norm_g = (const float*)w[4]; r.w_ada = (const float*)w[5]; r.b_ada = (const float*)w[6];
    r.w_in0 = (const float*)w[7]; r.sink0 = (const float*)w[8]; r.gm_ln_g = (const float*)w[9]; r.gm_ln_b = (const float*)w[10]; r.gm_ws = (const float*)w[11]; r.gm_bs = (const float*)w[12]; r.w_out0 = (const float*)w[13];
    r.w_in1 = (const float*)w[14]; r.q_norm = (const float*)w[15]; r.w_qb = (const float*)w[16]; r.kv_norm = (const float*)w[17]; r.w_kvb = (const float*)w[18]; r.w_out1 = (const float*)w[19]; r.final_g = (const float*)w[20];
    r.out = (float*)w[21]; r.ws = (unsigned char*)w[22];
#endif
    return r;
}
#define PHASE_BEGIN { const Params p = load_params(); bf16_t* const H = WSP(bf16_t, WS_H); bf16_t* const P0 = WSP(bf16_t, WS_P0); bf16_t* const MIX = WSP(bf16_t, WS_MIX); float* const MOD = WSP(float, WS_MOD); (void)H; (void)P0; (void)MIX; (void)MOD;
#define PHASE_END }
__global__ void __launch_bounds__(NTHREADS, 2) k_fwd(Params p_arg_unused) {
    extern __shared__ __attribute__((aligned(16))) unsigned char lds[];
    cg::grid_group grid = cg::this_grid();
    const int wid = __builtin_amdgcn_readfirstlane((int)threadIdx.x >> 6);
#define lane lane_id()
    volatile LAS unsigned* bst = (volatile LAS unsigned*)((LAS unsigned char*)lds + 131072 + 256);
    if (threadIdx.x < 2) bst[threadIdx.x] = 0u;
    __syncthreads();
    XcdBarrier bar; { const Params p0_ = load_params(); bar = xcd_barrier_post((unsigned*)(p0_.ws + WS_CTL) + 1024, bst); }
    const int G = gridDim.x, bid = blockIdx.x, vcu = (G % 8 == 0) ? (bid % 8) * (G / 8) + bid / 8 : bid;
    PG8_LAS unsigned char* glds = (PG8_LAS unsigned char*)lds;

    PHASE_BEGIN
#if OPT_S0
    { TH_LAS float* scr = (TH_LAS float*)lds + wid * (64 * 33);
      for (int it = vcu * NWAVES + wid; it < thin::WI_TOTAL; it += G * NWAVES) thin::stage0_item(p, it, scr, lane); }
#else
    naive_stage<0>(p); naive_stage<1>(p); naive_stage<2>(p);
#endif
    PHASE_END
    GRID_SYNC_CG();
    PHASE_BEGIN
#if OPT_NORM
    for (int rep_ = 0; rep_ < REP_NORM0; ++rep_) for (long r = (long)bid * NWAVES + wid; r < ROWS; r += (long)G * NWAVES) thin::modnorm_row(p, r, 0, lane);
#else
    naive_stage<3>(p);
#endif
    PHASE_END
    GRID_SYNC();
    PHASE_BEGIN
#if OPT_GEMM
#if GSEL_IN0
    for (int rep_ = 0; rep_ < REP_IN0; ++rep_) { pg8::Gemm g{H, WSP(bf16_t, WS_WIN0), ROWS, N_IN0, DM}; pg8::StaticOrder S; S.init(ROWS, N_IN0, G, bid);
      pg8::EpiIn0 E{P0, WSP(float, WS_ROPE0), WSP(float, WS_VVP)};
      pg8::gemm_phase<pg8::EpiIn0, pg8::StaticOrder, PG8_ALIGN, PG8_SP2>(glds, g, S, E); }
#endif
#else
    naive_stage<4>(p); GRID_SYNC(); naive_stage<5>(p);
#endif
    PHASE_END
    GRID_SYNC();
    PHASE_BEGIN
#if OPT_ATT0
    for (int rep_ = 0; rep_ < REP_ATT0; ++rep_) for (int u = vcu; u < NB * 64 + NB * 8; u += G) {
        att::Desc D; int b, h;
        if (u < NB * 64) { b = u >> 6; const int rem = u & 63, hk = rem >> 5, qb = (rem >> 2) & 7; h = hk * 4 + (rem & 3);
            const int q0 = qb * 256; int tl0 = q0 / 64 - 2; if (tl0 < 0) tl0 = 0; int tl1 = q0 / 64 + 5; if (tl1 > SEQ / 64 - 1) tl1 = SEQ / 64 - 1;
            D.qrow0 = (long)b * SEQ + q0; D.lat_row0 = (long)b * SEQ + 64 * tl0; D.ntl = tl1 - tl0 + 1; D.band_q0 = q0; D.band_k0 = 64 * tl0; }
        else { const int cu = u - NB * 64; b = cu >> 3; h = cu & 7; D.qrow0 = LROWS + (long)b * CTX; D.lat_row0 = 0; D.ntl = 0; D.band_q0 = 0; D.band_k0 = 0; }
        const int hk = h >> 2;
        D.Q = P0 + C_Q + 64 * h; D.qpitch = N_IN0; D.K = P0 + C_K + 64 * hk; D.kpitch = N_IN0; D.K2 = nullptr; D.k2pitch = 0; D.V = P0 + C_V + 64 * hk; D.vpitch = N_IN0;
        D.G = P0 + C_G + 64 * h; D.gpitch = N_IN0; D.O = MIX + 64 * h; D.opitch = DM; D.ctx_row0 = LROWS + (long)b * CTX; D.ntc = CTX / 64; D.sink = p.sink0[h] * LOG2E; D.has_sink = 1;
        if (u < NB * 64) att::unit<4, true>(D, (char*)lds); else att::unit<4, false>(D, (char*)lds);
    }
#else
    naive_stage<6>(p);
#endif
#if OPT_GMLP
    __syncthreads();
    for (int rep_ = 0; rep_ < REP_GMLP; ++rep_) for (int u = vcu; u < (ROWS / 128) * 8; u += G) thin::gmlp_unit(p, (long)(u >> 3) * 128, u & 7, (char*)lds);
#else
    naive_stage<7>(p);
#endif
    PHASE_END
    GRID_SYNC();
    PHASE_BEGIN
#if OPT_GEMM
#if GSEL_OUT0
    for (int rep_ = 0; rep_ < REP_OUT0; ++rep_) { pg8::Gemm g{MIX, WSP(bf16_t, WS_WOUT0), ROWS, DM, DM}; pg8::StaticOrder S; S.init(ROWS, DM, G, bid);
      pg8::EpiOut E{p.x, p.out, p.ctx, WSP(float, WS_X1C), MOD};
      pg8::gemm_phase<pg8::EpiOut, pg8::StaticOrder, PG8_ALIGN, PG8_SP2>(glds, g, S, E); }
#endif
#else
    naive_stage<8>(p);
#endif
    PHASE_END
    GRID_SYNC();
    PHASE_BEGIN
#if OPT_NORM
    for (int rep_ = 0; rep_ < REP_NORM1; ++rep_) for (long r = (long)bid * NWAVES + wid; r < ROWS; r += (long)G * NWAVES) thin::modnorm_row(p, r, 1, lane);
#else
    naive_stage<9>(p);
#endif
    PHASE_END
    GRID_SYNC();
    PHASE_BEGIN
#if OPT_GEMM
#if GSEL_IN1
    for (int rep_ = 0; rep_ < REP_IN1; ++rep_) { pg8::Gemm g{H, WSP(bf16_t, WS_WIN1), ROWS, N_IN1, DM}; pg8::ExtOrder S; S.init2(LROWS, N_IN1, G, bid, CROWS / 256, LROWS / 256, 1);
      pg8::EpiIn1 E{WSP(bf16_t, WS_QA), WSP(bf16_t, WS_KVA), WSP(bf16_t, WS_KPE), WSP(bf16_t, WS_G1), WSP(float, WS_QSP), WSP(float, WS_KVSP), WSP(float, WS_ROPE1)};
      pg8::gemm_phase<pg8::EpiIn1, pg8::ExtOrder, PG8_ALIGN, PG8_SP2>(glds, g, S, E); }
#endif
#else
    naive_stage<10>(p); GRID_SYNC(); naive_stage<11>(p);
#endif
    PHASE_END
    GRID_SYNC();
    PHASE_BEGIN
#if OPT_GEMM
#if GSEL_QB
    for (int rep_ = 0; rep_ < REP_QB; ++rep_) { pg8::Gemm g{WSP(bf16_t, WS_QA), WSP(bf16_t, WS_WQB), LROWS, 1536, 256}; pg8::StaticOrder S; S.init(LROWS, 1536, G, bid);
      pg8::EpiQb E{WSP(bf16_t, WS_Q1), WSP(float, WS_QSP), WSP(float, WS_ROPE1)};
      pg8::gemm_phase<pg8::EpiQb, pg8::StaticOrder, PG8_ALIGN, PG8_SP2>(glds, g, S, E); }
#endif
#if GSEL_KVB
    for (int rep_ = 0; rep_ < REP_KVB; ++rep_) { pg8::Gemm g{WSP(bf16_t, WS_KVA), WSP(bf16_t, WS_WKVB), ROWS, 2048, 256}; pg8::StaticOrder S; S.init(ROWS, 2048, G, (bid + G / 2) % G);
      pg8::EpiKvb E{WSP(bf16_t, WS_K1N), WSP(bf16_t, WS_V1), WSP(float, WS_KVSP)};
      pg8::gemm_phase<pg8::EpiKvb, pg8::StaticOrder, PG8_ALIGN, PG8_SP2>(glds, g, S, E); }
#endif
#else
    naive_stage<12>(p); naive_stage<13>(p);
#endif
    PHASE_END
    GRID_SYNC();
    PHASE_BEGIN
#if OPT_ATT1
    for (int rep_ = 0; rep_ < REP_ATT1; ++rep_) for (int u = vcu; u < NB * 16 * (SEQ / 256); u += G) {
        const int qb = u % (SEQ / 256), h = (u / (SEQ / 256)) & 15, b = u / (16 * (SEQ / 256)); att::Desc D;
        D.Q = WSP(bf16_t, WS_Q1) + 96 * h; D.qpitch = 1536; D.K = WSP(bf16_t, WS_K1N) + 64 * h; D.kpitch = DM; D.K2 = WSP(bf16_t, WS_KPE); D.k2pitch = 32;
        D.V = WSP(bf16_t, WS_V1) + 64 * h; D.vpitch = DM; D.G = WSP(bf16_t, WS_G1) + 64 * h; D.gpitch = DM; D.O = MIX + 64 * h; D.opitch = DM;
        D.qrow0 = (long)b * SEQ + qb * 256; D.lat_row0 = (long)b * SEQ; D.ntl = SEQ / 64; D.ctx_row0 = LROWS + (long)b * CTX; D.ntc = CTX / 64; D.band_q0 = 0; D.band_k0 = 0; D.sink = 0.f; D.has_sink = 0;
        att::unit<6, false>(D, (char*)lds);
    }
#else
    naive_stage<14>(p);
#endif
    PHASE_END
    GRID_SYNC();
    PHASE_BEGIN
#if OPT_GEMM
#if GSEL_OUT1
    { pg8::Gemm g{MIX, WSP(bf16_t, WS_WOUT1), LROWS, DM, DM}; pg8::StaticOrder S; S.init(LROWS, DM, G, bid);
      pg8::EpiOut E{p.out, p.out, nullptr, nullptr, MOD + 9 * 3072};
      pg8::gemm_phase<pg8::EpiOut, pg8::StaticOrder, PG8_ALIGN, PG8_SP2>(glds, g, S, E); }
#endif
#else
    naive_stage<15>(p);
#endif
    PHASE_END
    GRID_SYNC();
    PHASE_BEGIN
#if OPT_NORM
    for (long r = (long)bid * NWAVES + wid; r < LROWS; r += (long)G * NWAVES) thin::final_row(p, r, lane);
#else
    naive_stage<16>(p);
#endif
    PHASE_END
#undef lane
}

extern "C" void kernel_launch(void* const* d_in, const int* in_sizes, int n_in, void* d_out, int out_size, void* d_ws, size_t ws_size, hipStream_t stream) {
    if (n_in != 21 || ws_size < WS_END || out_size != LROWS * DM) { fprintf(stderr, "kernel_launch: unexpected sizes n_in %d out %d ws %zu (need %zu)\n", n_in, out_size, ws_size, (size_t)WS_END); return; }
    Params p{};
    const float** f = (const float**)&p;
    for (int i = 0; i < 21; ++i) f[i] = (const float*)d_in[i];
    p.out = (float*)d_out; p.ws = (unsigned char*)d_ws;
    static int grid_blocks = 0;
    if (!grid_blocks) {
        int dev = 0, cus = 0, per_cu = 0;
        hipGetDevice(&dev);
        hipDeviceGetAttribute(&cus, hipDeviceAttributeMultiprocessorCount, dev);
        if (hipFuncSetAttribute((const void*)k_fwd, hipFuncAttributeMaxDynamicSharedMemorySize, LDS_BYTES) != hipSuccess) fprintf(stderr, "kernel_launch: hipFuncSetAttribute(%d B dynamic LDS) failed\n", LDS_BYTES);
        hipOccupancyMaxActiveBlocksPerMultiprocessor(&per_cu, k_fwd, NTHREADS, LDS_BYTES);
        if (per_cu < 1) { fprintf(stderr, "kernel_launch: occupancy query says %d blocks/CU\n", per_cu); per_cu = 1; }
        grid_blocks = cus;
    }
    hipMemsetAsync((char*)d_ws + WS_MOD, 0, (size_t)2 * 9 * 3072 * 4, stream);
    hipMemsetAsync((char*)d_ws + WS_CTL, 0, 65536, stream);
    void* args[] = {&p};
    hipError_t e = hipLaunchCooperativeKernel((void*)k_fwd, dim3(grid_blocks), dim3(NTHREADS), args, LDS_BYTES, stream);
    if (e != hipSuccess) fprintf(stderr, "cooperative launch failed: %s (grid %d)\n", hipGetErrorString(e), grid_blocks);
}
#else
static std::vector<float> readf(const char* path, size_t n) { std::vector<float> v(n); FILE* f = fopen(path, "rb"); if (!f) { printf("cannot open %s\n", path); exit(1); } size_t g = fread(v.data(), 4, n, f); fclose(f); if (g != n) { printf("short read %s %zu/%zu\n", path, g, n); exit(1); } return v; }
static void cmp(const char* name, const float* a, const float* b, size_t n) { double e = 0, s = 0, mx = 0; for (size_t i = 0; i < n; ++i) { double d = (double)a[i] - b[i]; e += d * d; s += (double)b[i] * b[i]; if (fabs(d) > mx) mx = fabs(d); }
    printf("%-8s rvr %.3e  rel %.3e  absmax %.3e  (ref rms %.4f)\n", name, e / s, sqrt(e / s), mx, sqrt(s / n)); }
int main(int argc, char** argv) {
    const char* dir = argc > 1 ? argv[1] : "data"; char path[512];
    const size_t sizes[21] = {(size_t)LROWS * DM, (size_t)NB * DM, (size_t)CROWS * DM, DM, 2 * DM, 2u * DM * 3072, 2 * 3072, (size_t)DM * N_IN0, 8, 512, 512, 8 * 128 * 128, 8 * 128, (size_t)DM * DM,
                              (size_t)DM * 1440, 256, 256 * 1536, 128, 128 * 2048, (size_t)DM * DM, DM};
    size_t tot = 0; for (int i = 0; i < 21; ++i) tot += sizes[i];
    snprintf(path, sizeof path, "%s/inputs.bin", dir); std::vector<float> in = readf(path, tot);
    Params p{}; const float** f = (const float**)&p; size_t off = 0; for (int i = 0; i < 21; ++i) { f[i] = in.data() + off; off += sizes[i]; }
    std::vector<float> out((size_t)LROWS * DM, NAN); std::vector<unsigned char> ws(WS_END, 0xAA); p.out = out.data(); p.ws = ws.data();
    auto dump_bf = [&](const char* nm, size_t wsoff, size_t rows, size_t pitch, size_t c0, size_t ncol, float scale) {
        snprintf(path, sizeof path, "%s/dbg_%s.bin", dir, nm); std::vector<float> ref = readf(path, rows * ncol); std::vector<float> mine(rows * ncol);
        const bf16_t* b = (const bf16_t*)(ws.data() + wsoff); for (size_t r = 0; r < rows; ++r) for (size_t c = 0; c < ncol; ++c) mine[r * ncol + c] = bf2f(b[r * pitch + c0 + c]) * scale; cmp(nm, mine.data(), ref.data(), rows * ncol); };
    for (int s = 0; s <= N_STAGES; ++s) {
        long n = stage_items(s);
#pragma omp parallel for schedule(dynamic, 256)
        for (long it = 0; it < n; ++it) stage_item(p, s, it);
        if (s == 3) {
            snprintf(path, sizeof path, "%s/dbg_h0.bin", dir); std::vector<float> ref = readf(path, (size_t)ROWS * DM); std::vector<float> mine((size_t)ROWS * DM); const bf16_t* H = (const bf16_t*)(ws.data() + WS_H);
            for (int b = 0; b < NB; ++b) for (int j = 0; j < SEQ + CTX; ++j) { size_t r = j < SEQ ? (size_t)b * SEQ + j : LROWS + (size_t)b * CTX + j - SEQ; for (int c = 0; c < DM; ++c) mine[((size_t)b * (SEQ + CTX) + j) * DM + c] = bf2f(H[r * DM + c]); }
            cmp("h0", mine.data(), ref.data(), mine.size()); }
        if (s == 4) { dump_bf("q0", WS_P0, LROWS, N_IN0, C_Q, 512, 1.0f / QSCALE0); dump_bf("k0", WS_P0, LROWS, N_IN0, C_K, 128, 1.0f); }
        if (s == 7) { snprintf(path, sizeof path, "%s/dbg_mix0.bin", dir); std::vector<float> ref = readf(path, (size_t)ROWS * DM); std::vector<float> mine((size_t)ROWS * DM); const bf16_t* H = (const bf16_t*)(ws.data() + WS_MIX);
            for (int b = 0; b < NB; ++b) for (int j = 0; j < SEQ + CTX; ++j) { size_t r = j < SEQ ? (size_t)b * SEQ + j : LROWS + (size_t)b * CTX + j - SEQ; for (int c = 0; c < DM; ++c) mine[((size_t)b * (SEQ + CTX) + j) * DM + c] = bf2f(H[r * DM + c]); }
            cmp("mix0", mine.data(), ref.data(), mine.size()); }
        if (s == 8) { snprintf(path, sizeof path, "%s/dbg_x1.bin", dir); std::vector<float> ref = readf(path, (size_t)LROWS * DM); cmp("x1", out.data(), ref.data(), ref.size()); }
        if (s == 9) { snprintf(path, sizeof path, "%s/dbg_h1.bin", dir); std::vector<float> ref = readf(path, (size_t)ROWS * DM); std::vector<float> mine((size_t)ROWS * DM); const bf16_t* H = (const bf16_t*)(ws.data() + WS_H);
            for (int b = 0; b < NB; ++b) for (int j = 0; j < SEQ + CTX; ++j) { size_t r = j < SEQ ? (size_t)b * SEQ + j : LROWS + (size_t)b * CTX + j - SEQ; for (int c = 0; c < DM; ++c) mine[((size_t)b * (SEQ + CTX) + j) * DM + c] = bf2f(H[r * DM + c]); }
            cmp("h1", mine.data(), ref.data(), mine.size()); }
        if (s == 12) {
            snprintf(path, sizeof path, "%s/dbg_q1.bin", dir); std::vector<float> ref = readf(path, (size_t)LROWS * 1536); std::vector<float> mine((size_t)LROWS * 1536); const bf16_t* Q = (const bf16_t*)(ws.data() + WS_Q1);
            for (size_t r = 0; r < (size_t)LROWS; ++r) for (int c = 0; c < 1536; ++c) { int h = c / 96, w = c % 96; int oc = h * 96 + (w < 64 ? w : 64 + pe_orig(w - 64)); mine[r * 1536 + oc] = bf2f(Q[r * 1536 + c]) / QSCALE1; }
            cmp("q1", mine.data(), ref.data(), mine.size()); }
        if (s == 15) { snprintf(path, sizeof path, "%s/dbg_x2.bin", dir); std::vector<float> ref = readf(path, (size_t)LROWS * DM); cmp("x2", out.data(), ref.data(), ref.size()); }
    }
    snprintf(path, sizeof path, "%s/out.bin", dir); std::vector<float> ref = readf(path, (size_t)LROWS * DM); cmp("out", out.data(), ref.data(), ref.size());
    return 0;
}
#endif
```

```cpp
#ifndef HOST_TEST
#include <hip/hip_runtime.h>
#include <hip/hip_cooperative_groups.h>
#include <cstdio>
#define HD __device__ __forceinline__
#else
#include <cstdio>
#include <cstdlib>
#include <cstring>
#include <cmath>
#include <vector>
#define HD static inline
#endif
#include <cstdint>

#ifndef CFG_B
#define CFG_B 8
#endif
#ifndef CFG_S
#define CFG_S 2048
#endif
#ifndef CFG_C
#define CFG_C 256
#endif
constexpr int NB = CFG_B, SEQ = CFG_S, CTX = CFG_C, DM = 1024, GRIDW = 64;
constexpr int LROWS = NB * SEQ, CROWS = NB * CTX, ROWS = LROWS + CROWS;
constexpr int N_IN0 = 2816, N_IN1 = 1536;
constexpr int C_Q = 0, C_K = 512, C_V = 640, C_U = 768, C_VV = 1280, C_G = 1792;
constexpr float LOG2E = 1.4426950408889634f;
constexpr float QSCALE0 = 0.125f * LOG2E;
constexpr float QSCALE1 = 0.10206207261596577f * LOG2E;
constexpr float NORM_EPS = 1e-6f;

typedef unsigned short bf16_t;

constexpr size_t al(size_t x) { return (x + 4095) & ~(size_t)4095; }
constexpr size_t WS_CTL = 0;
constexpr size_t WS_WIN0 = 1u << 20;
constexpr size_t WS_WOUT0 = WS_WIN0 + al((size_t)N_IN0 * DM * 2);
constexpr size_t WS_WIN1 = WS_WOUT0 + al((size_t)DM * DM * 2);
constexpr size_t WS_WQB = WS_WIN1 + al((size_t)N_IN1 * DM * 2);
constexpr size_t WS_WKVB = WS_WQB + al((size_t)1536 * 256 * 2);
constexpr size_t WS_WOUT1 = WS_WKVB + al((size_t)2048 * 256 * 2);
constexpr size_t WS_WS = WS_WOUT1 + al((size_t)DM * DM * 2);
constexpr size_t WS_MOD = WS_WS + al((size_t)8 * 128 * 128 * 2);
constexpr size_t WS_ROPE0 = WS_MOD + al((size_t)2 * 9 * 3072 * 4);
constexpr size_t WS_ROPE1 = WS_ROPE0 + al((size_t)SEQ * 32 * 2 * 4);
constexpr size_t WS_VVP = WS_ROPE1 + al((size_t)SEQ * 16 * 2 * 4);
constexpr size_t WS_QSP = WS_VVP + al((size_t)ROWS * 16 * 4);
constexpr size_t WS_KVSP = WS_QSP + al((size_t)LROWS * 4 * 4);
constexpr size_t WS_KPE = WS_KVSP + al((size_t)ROWS * 4 * 4);
constexpr size_t WS_KVA = WS_KPE + al((size_t)ROWS * 32 * 2);
constexpr size_t WS_X1C = WS_KVA + al((size_t)ROWS * 256 * 2);
constexpr size_t WS_H = WS_X1C + al((size_t)CROWS * DM * 4);
constexpr size_t WS_K1N = WS_H;
constexpr size_t WS_P0 = WS_H + al((size_t)ROWS * DM * 2);
constexpr size_t WS_Q1 = WS_P0;
constexpr size_t WS_G1 = WS_Q1 + al((size_t)LROWS * 1536 * 2);
constexpr size_t WS_QA = WS_G1 + al((size_t)LROWS * DM * 2);
constexpr size_t WS_MIX = WS_P0 + al((size_t)ROWS * N_IN0 * 2);
constexpr size_t WS_V1 = WS_MIX + al((size_t)ROWS * DM * 2);
constexpr size_t WS_END = WS_V1 + al((size_t)ROWS * DM * 2);
static_assert(WS_QA + (size_t)LROWS * 256 * 2 <= WS_MIX, "layer-1 overlay fits in P0");
static_assert(WS_END <= (size_t)256 << 20, "workspace fits in 256 MiB");

struct Params {
    const float *x, *c, *ctx, *c_ctx, *norm_g, *w_ada, *b_ada, *w_in0, *sink0, *gm_ln_g, *gm_ln_b, *gm_ws, *gm_bs, *w_out0,
        *w_in1, *q_norm, *w_qb, *kv_norm, *w_kvb, *w_out1, *final_g;
    float* out;
    unsigned char* ws;
};

HD float bf2f(bf16_t v) { unsigned u = (unsigned)v << 16; float f; memcpy(&f, &u, 4); return f; }
HD bf16_t f2bf(float f) { unsigned u; memcpy(&u, &f, 4); return (bf16_t)((u + 0x7fffu + ((u >> 16) & 1u)) >> 16); }
HD float silu_f(float v) { return v / (1.0f + expf(-v)); }
HD float gelu_f(float v) { return 0.5f * v * (1.0f + erff(v * 0.70710678118654752f)); }
HD int pe_orig(int p) { return p < 8 ? p : (p < 16 ? p + 8 : (p < 24 ? p - 8 : p)); }

#define WSP(T, off) ((T*)(p.ws + (off)))

constexpr long W_ITEMS0 = (long)N_IN0 * DM, W_ITEMS1 = (long)DM * DM, W_ITEMS2 = (long)N_IN1 * DM, W_ITEMS3 = 1536L * 256, W_ITEMS4 = 2048L * 256,
               W_ITEMS5 = (long)DM * DM, W_ITEMS6 = 8L * 128 * 128;
constexpr long W_ITEMS = W_ITEMS0 + W_ITEMS1 + W_ITEMS2 + W_ITEMS3 + W_ITEMS4 + W_ITEMS5 + W_ITEMS6;
HD void nk_weights(const Params& p, long it) {
    if (it < W_ITEMS0) { int n = (int)(it / DM), k = (int)(it % DM); WSP(bf16_t, WS_WIN0)[it] = f2bf(p.w_in0[(size_t)k * N_IN0 + n]); return; } it -= W_ITEMS0;
    if (it < W_ITEMS1) { int n = (int)(it / DM), k = (int)(it % DM); WSP(bf16_t, WS_WOUT0)[it] = f2bf(p.w_out0[(size_t)k * DM + n]); return; } it -= W_ITEMS1;
    if (it < W_ITEMS2) { int n = (int)(it / DM), k = (int)(it % DM); float v = 0.f;
        if (n < 416) v = p.w_in1[(size_t)k * 1440 + (n < 384 ? n : 384 + pe_orig(n - 384))]; else if (n >= 512) v = p.w_in1[(size_t)k * 1440 + n - 96];
        WSP(bf16_t, WS_WIN1)[it] = f2bf(v); return; } it -= W_ITEMS2;
    if (it < W_ITEMS3) { int n = (int)(it / 256), k = (int)(it % 256); int h = n / 96, w = n % 96; int oc = h * 96 + (w < 64 ? w : 64 + pe_orig(w - 64));
        WSP(bf16_t, WS_WQB)[it] = f2bf(p.w_qb[(size_t)k * 1536 + oc] * p.q_norm[k]); return; } it -= W_ITEMS3;
    if (it < W_ITEMS4) { int n = (int)(it / 256), k = (int)(it % 256); int nn = n & 1023, h = nn >> 6, d = nn & 63; int oc = h * 128 + d + (n >= 1024 ? 64 : 0);
        WSP(bf16_t, WS_WKVB)[it] = k < 128 ? f2bf(p.w_kvb[(size_t)k * 2048 + oc] * p.kv_norm[k]) : (bf16_t)0; return; } it -= W_ITEMS4;
    if (it < W_ITEMS5) { int n = (int)(it / DM), k = (int)(it % DM); WSP(bf16_t, WS_WOUT1)[it] = f2bf(p.w_out1[(size_t)k * DM + n]); return; } it -= W_ITEMS5;
    WSP(bf16_t, WS_WS)[it] = f2bf(p.gm_ws[it]);
}
constexpr long ROPE_ITEMS = (long)SEQ * 48;
HD void nk_rope(const Params& p, long it) {
    int s = (int)(it / 48), t = (int)(it % 48); float pr = (float)(s / GRIDW), pc = (float)(s % GRIDW);
    if (t < 32) { int j = t & 15; float inv = exp2f(-(float)j * (13.287712379549449f / 16.0f)); float a = (t < 16 ? pr : pc) * inv;
        float* o = WSP(float, WS_ROPE0) + ((size_t)s * 32 + t) * 2; o[0] = cosf(a); o[1] = sinf(a); }
    else { int u = t - 32, j = u & 7; float inv = exp2f(-(float)j * (13.287712379549449f / 8.0f)); float a = (u < 8 ? pr : pc) * inv;
        float* o = WSP(float, WS_ROPE1) + ((size_t)s * 16 + u) * 2; o[0] = cosf(a); o[1] = sinf(a); }
}
constexpr long ADA_ITEMS = 2L * 3072;
HD void nk_adaln(const Params& p, long it) {
    int l = (int)(it / 3072), n = (int)(it % 3072); float acc[9];
#pragma unroll
    for (int r = 0; r < 9; ++r) acc[r] = 0.f;
    const float* w = p.w_ada + (size_t)l * DM * 3072 + n;
    for (int k = 0; k < DM; ++k) { float wv = w[(size_t)k * 3072];
#pragma unroll
        for (int r = 0; r < 9; ++r) { float cv = (r < 8) ? (r < NB ? p.c[r * DM + k] : 0.f) : p.c_ctx[k]; acc[r] += silu_f(cv) * wv; } }
    float bb = p.b_ada[l * 3072 + n];
#pragma unroll
    for (int r = 0; r < 9; ++r) WSP(float, WS_MOD)[((size_t)l * 9 + r) * 3072 + n] = acc[r] + bb;
}
HD void nk_modnorm(const Params& p, long r, int layer) {
    const float* src; int mr;
    if (r < LROWS) { src = (layer == 0 ? p.x : p.out) + (size_t)r * DM; mr = (int)(r / SEQ); }
    else { src = (layer == 0 ? p.ctx : WSP(float, WS_X1C)) + (size_t)(r - LROWS) * DM; mr = 8; }
    float ss = 0.f; for (int k = 0; k < DM; ++k) ss += src[k] * src[k];
    float rstd = 1.0f / sqrtf(ss / DM + NORM_EPS);
    const float* md = WSP(float, WS_MOD) + ((size_t)layer * 9 + mr) * 3072; const float* g = p.norm_g + layer * DM;
    bf16_t* o = WSP(bf16_t, WS_H) + (size_t)r * DM;
    for (int k = 0; k < DM; ++k) o[k] = f2bf(src[k] * rstd * g[k] * (1.0f + md[1024 + k]) + md[k]);
}
HD float nk_dot(const bf16_t* a, const bf16_t* b, int K) { float s = 0.f; for (int k = 0; k < K; ++k) s += bf2f(a[k]) * bf2f(b[k]); return s; }
constexpr long IN0_ITEMS = (long)ROWS * N_IN0;
HD void nk_in0(const Params& p, long it) {
    long r = it / N_IN0; int c = (int)(it % N_IN0);
    const bf16_t* a = WSP(bf16_t, WS_H) + (size_t)r * DM; const bf16_t* W = WSP(bf16_t, WS_WIN0);
    float v = nk_dot(a, W + (size_t)c * DM, DM), o;
    if (c < C_V) {
        if (r < LROWS) { int d = c & 63, t = d & 15, second = (d >> 4) & 1, ax = d >> 5; int pc = second ? c - 16 : c + 16;
            float v2 = nk_dot(a, W + (size_t)pc * DM, DM); int s = (int)(r % SEQ); const float* cs = WSP(float, WS_ROPE0) + ((size_t)s * 32 + ax * 16 + t) * 2;
            o = second ? (v2 * cs[1] + v * cs[0]) : (v * cs[0] - v2 * cs[1]); }
        else o = v;
        if (c < C_K) o *= QSCALE0;
    } else if (c < C_U) o = v;
    else if (c < C_G) o = gelu_f(v);
    else o = silu_f(v);
    WSP(bf16_t, WS_P0)[it] = f2bf(o);
}
constexpr long VVP_ITEMS = (long)ROWS * 8;
HD void nk_vvp(const Params& p, long it) {
    long r = it / 8; int j = (int)(it % 8); const bf16_t* v = WSP(bf16_t, WS_P0) + (size_t)r * N_IN0 + C_VV + 64 * j; float s = 0.f, q = 0.f;
    for (int i = 0; i < 64; ++i) { float f = bf2f(v[i]); s += f; q += f * f; }
    float* o = WSP(float, WS_VVP) + it * 2; o[0] = s; o[1] = q;
}
constexpr long ATT0_ITEMS = (long)ROWS * 8;
HD void nk_attn0(const Params& p, long it) {
    int h = (int)(it / ROWS); long r = it % ROWS; int hk = h >> 2;
    const bf16_t* P0 = WSP(bf16_t, WS_P0); const bf16_t* qp = P0 + (size_t)r * N_IN0 + C_Q + 64 * h;
    float q[64], o[64];
#pragma unroll
    for (int d = 0; d < 64; ++d) { q[d] = bf2f(qp[d]); o[d] = 0.f; }
    float m = -1e30f, l = 0.f;
    int b, j0 = 0, j1 = 0; long cbase;
    if (r < LROWS) { b = (int)(r / SEQ); int s = (int)(r % SEQ); j0 = s - 128 < 0 ? 0 : s - 128; j1 = s + 128 > SEQ - 1 ? SEQ - 1 : s + 128; }
    else { b = (int)((r - LROWS) / CTX); j0 = 1; j1 = 0; }
    cbase = LROWS + (long)b * CTX;
    const int nloc = j1 - j0 + 1 > 0 ? j1 - j0 + 1 : 0;
    for (int t = 0; t < nloc + CTX; ++t) {
        long kr = t < nloc ? (long)b * SEQ + j0 + t : cbase + (t - nloc);
        const bf16_t* kp = P0 + (size_t)kr * N_IN0 + C_K + 64 * hk; const bf16_t* vp = P0 + (size_t)kr * N_IN0 + C_V + 64 * hk;
        float s = 0.f;
#pragma unroll
        for (int d = 0; d < 64; ++d) s += q[d] * bf2f(kp[d]);
        float mn = s > m ? s : m, a = exp2f(m - mn), pp = exp2f(s - mn); l = l * a + pp; m = mn;
#pragma unroll
        for (int d = 0; d < 64; ++d) o[d] = o[d] * a + pp * bf2f(vp[d]);
    }
    { float s = p.sink0[h] * LOG2E; float mn = s > m ? s : m, a = exp2f(m - mn), pp = exp2f(s - mn); l = l * a + pp;
#pragma unroll
      for (int d = 0; d < 64; ++d) o[d] *= a; }
    const bf16_t* gp = P0 + (size_t)r * N_IN0 + C_G + 64 * h; bf16_t* op = WSP(bf16_t, WS_MIX) + (size_t)r * DM + 64 * h; float rl = 1.0f / l;
#pragma unroll
    for (int d = 0; d < 64; ++d) op[d] = f2bf(o[d] * rl * bf2f(gp[d]));
}
constexpr long GMLP_ITEMS = (long)ROWS * 512;
HD void nk_gmlp(const Params& p, long it) {
    long r = it / 512; int c = (int)(it % 512), g = c >> 6, pp = (int)(r & 127); long r0 = r - pp;
    const bf16_t* P0 = WSP(bf16_t, WS_P0); const bf16_t* W = WSP(bf16_t, WS_WS) + ((size_t)g * 128 + pp) * 128; const float* vvp = WSP(float, WS_VVP);
    float lg = p.gm_ln_g[c], lb = p.gm_ln_b[c], s = 0.f;
    for (int q = 0; q < 128; ++q) { const float* pt = vvp + (size_t)(r0 + q) * 16; float sm = 0.f, sq = 0.f;
        for (int j = 0; j < 8; ++j) { sm += pt[2 * j]; sq += pt[2 * j + 1]; }
        float mean = sm * (1.0f / 512), var = sq * (1.0f / 512) - mean * mean, rstd = 1.0f / sqrtf(var + NORM_EPS);
        float vn = bf2f(f2bf((bf2f(P0[(size_t)(r0 + q) * N_IN0 + C_VV + c]) - mean) * rstd * lg + lb));
        s += bf2f(W[q]) * vn; }
    s += p.gm_bs[g * 128 + pp];
    float u = bf2f(P0[(size_t)r * N_IN0 + C_U + c]), gt = bf2f(P0[(size_t)r * N_IN0 + C_G + 512 + c]);
    WSP(bf16_t, WS_MIX)[(size_t)r * DM + 512 + c] = f2bf(u * s * gt);
}
constexpr long OUT0_ITEMS = (long)ROWS * DM;
HD void nk_out0(const Params& p, long it) {
    long r = it / DM; int c = (int)(it % DM);
    float y = nk_dot(WSP(bf16_t, WS_MIX) + (size_t)r * DM, WSP(bf16_t, WS_WOUT0) + (size_t)c * DM, DM);
    if (r < LROWS) { int b = (int)(r / SEQ); p.out[it] = p.x[it] + WSP(float, WS_MOD)[(size_t)b * 3072 + 2048 + c] * y; }
    else { size_t ci = (size_t)(r - LROWS) * DM + c; WSP(float, WS_X1C)[ci] = p.ctx[ci] + WSP(float, WS_MOD)[(size_t)8 * 3072 + 2048 + c] * y; }
}
constexpr long IN1_ITEMS = (long)ROWS * N_IN1;
HD void nk_in1(const Params& p, long it) {
    long r = it / N_IN1; int c = (int)(it % N_IN1);
    if (c >= 384 && c < 512) WSP(bf16_t, WS_KVA)[(size_t)r * 256 + 128 + c - 384] = 0;
    if (c >= 416 && c < 512) return;
    if (r >= LROWS && (c < 256 || c >= 416)) return;
    const bf16_t* a = WSP(bf16_t, WS_H) + (size_t)r * DM; const bf16_t* W = WSP(bf16_t, WS_WIN1);
    float v = nk_dot(a, W + (size_t)c * DM, DM);
    if (c < 256) WSP(bf16_t, WS_QA)[(size_t)r * 256 + c] = f2bf(v);
    else if (c < 384) WSP(bf16_t, WS_KVA)[(size_t)r * 256 + c - 256] = f2bf(v);
    else if (c < 416) { int pp = c - 384; float o = v;
        if (r < LROWS) { int second = pp >> 4, t = pp & 15; int pc = second ? c - 16 : c + 16; float v2 = nk_dot(a, W + (size_t)pc * DM, DM);
            int s = (int)(r % SEQ); const float* cs = WSP(float, WS_ROPE1) + ((size_t)s * 16 + t) * 2;
            o = second ? (v2 * cs[1] + v * cs[0]) : (v * cs[0] - v2 * cs[1]); }
        WSP(bf16_t, WS_KPE)[(size_t)r * 32 + pp] = f2bf(o); }
    else WSP(bf16_t, WS_G1)[(size_t)r * DM + c - 512] = f2bf(silu_f(v));
}
constexpr long SSP_ITEMS = (long)ROWS * 8;
HD void nk_ssp(const Params& p, long it) {
    long r = it / 8; int j = (int)(it % 8);
    if (j < 4) { if (r >= LROWS) return; const bf16_t* v = WSP(bf16_t, WS_QA) + (size_t)r * 256 + 64 * j; float q = 0.f; for (int i = 0; i < 64; ++i) { float f = bf2f(v[i]); q += f * f; }
        WSP(float, WS_QSP)[r * 4 + j] = q; }
    else { j -= 4; const bf16_t* v = WSP(bf16_t, WS_KVA) + (size_t)r * 256 + 32 * j; float q = 0.f; for (int i = 0; i < 32; ++i) { float f = bf2f(v[i]); q += f * f; }
        WSP(float, WS_KVSP)[r * 4 + j] = q; }
}
constexpr long QB_ITEMS = (long)LROWS * 1536;
HD void nk_qb(const Params& p, long it) {
    long r = it / 1536; int c = (int)(it % 1536); int w = c % 96;
    const bf16_t* a = WSP(bf16_t, WS_QA) + (size_t)r * 256; const bf16_t* W = WSP(bf16_t, WS_WQB);
    const float* sp = WSP(float, WS_QSP) + r * 4; float rstd = 1.0f / sqrtf((sp[0] + sp[1] + sp[2] + sp[3]) * (1.0f / 256) + NORM_EPS);
    float v = nk_dot(a, W + (size_t)c * 256, 256) * rstd, o = v;
    if (w >= 64) { int pp = w - 64, second = pp >> 4, t = pp & 15; int pc = second ? c - 16 : c + 16; float v2 = nk_dot(a, W + (size_t)pc * 256, 256) * rstd;
        int s = (int)(r % SEQ); const float* cs = WSP(float, WS_ROPE1) + ((size_t)s * 16 + t) * 2;
        o = second ? (v2 * cs[1] + v * cs[0]) : (v * cs[0] - v2 * cs[1]); }
    WSP(bf16_t, WS_Q1)[it] = f2bf(o * QSCALE1);
}
constexpr long KVB_ITEMS = (long)ROWS * 2048;
HD void nk_kvb(const Params& p, long it) {
    long r = it / 2048; int c = (int)(it % 2048);
    const float* sp = WSP(float, WS_KVSP) + r * 4; float rstd = 1.0f / sqrtf((sp[0] + sp[1] + sp[2] + sp[3]) * (1.0f / 128) + NORM_EPS);
    float v = nk_dot(WSP(bf16_t, WS_KVA) + (size_t)r * 256, WSP(bf16_t, WS_WKVB) + (size_t)c * 256, 256) * rstd;
    if (c < 1024) WSP(bf16_t, WS_K1N)[(size_t)r * DM + c] = f2bf(v); else WSP(bf16_t, WS_V1)[(size_t)r * DM + c - 1024] = f2bf(v);
}
constexpr long ATT1_ITEMS = (long)LROWS * 16;
HD void nk_attn1(const Params& p, long it) {
    int h = (int)(it / LROWS); long r = it % LROWS; int b = (int)(r / SEQ);
    const bf16_t* qp = WSP(bf16_t, WS_Q1) + (size_t)r * 1536 + 96 * h;
    float q[96], o[64];
#pragma unroll
    for (int d = 0; d < 96; ++d) q[d] = bf2f(qp[d]);
#pragma unroll
    for (int d = 0; d < 64; ++d) o[d] = 0.f;
    float m = -1e30f, l = 0.f;
    for (int t = 0; t < SEQ + CTX; ++t) {
        long kr = t < SEQ ? (long)b * SEQ + t : LROWS + (long)b * CTX + (t - SEQ);
        const bf16_t* kn = WSP(bf16_t, WS_K1N) + (size_t)kr * DM + 64 * h; const bf16_t* kp = WSP(bf16_t, WS_KPE) + (size_t)kr * 32; const bf16_t* vp = WSP(bf16_t, WS_V1) + (size_t)kr * DM + 64 * h;
        float s = 0.f;
#pragma unroll
        for (int d = 0; d < 64; ++d) s += q[d] * bf2f(kn[d]);
#pragma unroll
        for (int d = 0; d < 32; ++d) s += q[64 + d] * bf2f(kp[d]);
        float mn = s > m ? s : m, a = exp2f(m - mn), pp = exp2f(s - mn); l = l * a + pp; m = mn;
#pragma unroll
        for (int d = 0; d < 64; ++d) o[d] = o[d] * a + pp * bf2f(vp[d]);
    }
    const bf16_t* gp = WSP(bf16_t, WS_G1) + (size_t)r * DM + 64 * h; bf16_t* op = WSP(bf16_t, WS_MIX) + (size_t)r * DM + 64 * h; float rl = 1.0f / l;
#pragma unroll
    for (int d = 0; d < 64; ++d) op[d] = f2bf(o[d] * rl * bf2f(gp[d]));
}
constexpr long OUT1_ITEMS = (long)LROWS * DM;
HD void nk_out1(const Params& p, long it) {
    long r = it / DM; int c = (int)(it % DM); int b = (int)(r / SEQ);
    float y = nk_dot(WSP(bf16_t, WS_MIX) + (size_t)r * DM, WSP(bf16_t, WS_WOUT1) + (size_t)c * DM, DM);
    p.out[it] = p.out[it] + WSP(float, WS_MOD)[((size_t)9 + b) * 3072 + 2048 + c] * y;
}
HD void nk_final(const Params& p, long r) {
    float* o = p.out + (size_t)r * DM; float ss = 0.f; for (int k = 0; k < DM; ++k) ss += o[k] * o[k];
    float rstd = 1.0f / sqrtf(ss / DM + NORM_EPS);
    for (int k = 0; k < DM; ++k) o[k] = o[k] * rstd * p.final_g[k];
}

constexpr int N_STAGES = 16;
#ifndef HOST_TEST
__host__ __device__ inline
#else
static inline
#endif
long stage_items(int s) {
    switch (s) { case 0: return W_ITEMS; case 1: return ROPE_ITEMS; case 2: return ADA_ITEMS; case 3: return ROWS; case 4: return IN0_ITEMS; case 5: return VVP_ITEMS;
        case 6: return ATT0_ITEMS; case 7: return GMLP_ITEMS; case 8: return OUT0_ITEMS; case 9: return ROWS; case 10: return IN1_ITEMS; case 11: return SSP_ITEMS;
        case 12: return QB_ITEMS; case 13: return KVB_ITEMS; case 14: return ATT1_ITEMS; case 15: return OUT1_ITEMS; default: return LROWS; }
}
HD void stage_item(const Params& p, int s, long it) {
    switch (s) { case 0: nk_weights(p, it); break; case 1: nk_rope(p, it); break; case 2: nk_adaln(p, it); break; case 3: nk_modnorm(p, it, 0); break; case 4: nk_in0(p, it); break;
        case 5: nk_vvp(p, it); break; case 6: nk_attn0(p, it); break; case 7: nk_gmlp(p, it); break; case 8: nk_out0(p, it); break; case 9: nk_modnorm(p, it, 1); break;
        case 10: nk_in1(p, it); break; case 11: nk_ssp(p, it); break; case 12: nk_qb(p, it); break; case 13: nk_kvb(p, it); break; case 14: nk_attn1(p, it); break;
        case 15: nk_out1(p, it); break; default: nk_final(p, it); break; }
}
HD bool stage_sync_after(int s) { return !(s == 0 || s == 1 || s == 6 || s == 12); }

#ifndef HOST_TEST
#include <hip/hip_bf16.h>
__device__ __forceinline__ int lane_id() { return (int)__builtin_amdgcn_mbcnt_hi(~0u, __builtin_amdgcn_mbcnt_lo(~0u, 0u)); }
__device__ __forceinline__ int tid_rebuilt() { return __builtin_amdgcn_readfirstlane((int)threadIdx.x >> 6) * 64 + lane_id(); }
template <int X> __device__ __forceinline__ float xshfl(float v) {
    if constexpr (X < 32) return __int_as_float(__builtin_amdgcn_ds_swizzle(__float_as_int(v), 0x1F | (X << 10)));
    else { auto rr = __builtin_amdgcn_permlane32_swap(__float_as_uint(v), __float_as_uint(v), false, false); return __uint_as_float(rr[0] == __float_as_uint(v) ? rr[1] : rr[0]); }
}
__device__ __forceinline__ float xsum32(float v) { auto rr = __builtin_amdgcn_permlane32_swap(__float_as_uint(v), __float_as_uint(v), false, false); return __uint_as_float(rr[0]) + __uint_as_float(rr[1]); }
namespace pg8 {
#define PG8_LAS __attribute__((address_space(3)))
typedef unsigned short bf16_t;
typedef short bf16x8 __attribute__((ext_vector_type(8)));
typedef float f32x4 __attribute__((ext_vector_type(4)));
typedef unsigned u32x4 __attribute__((ext_vector_type(4)));
constexpr int BM = 256, BK = 64, HALF = 128, HTB = HALF * BK * 2  , STAGE_BYTES = 8 * HTB, NXCD = 8, WGM = 8;

__host__ __device__ __forceinline__ int lds_byte(int r, int c) { const int st = (r >> 4) * 2 + (c >> 5), rr = r & 15, cc = c & 31, ob = rr * 64 + cc * 2; return st * 1024 + (ob ^ (((ob >> 9) & 1) << 5)); }
__host__ __device__ __forceinline__ void stage_rc(int b, int& R, int& C) { const int st = b / 1024, sb = b % 1024, swz = sb ^ (((sb >> 9) & 1) << 5); R = (st >> 1) * 16 + swz / 64; C = (st & 1) * 32 + (swz % 64) / 2; }
__host__ __device__ __forceinline__ int perm32(int rho) { const int n = rho >> 4, i = rho & 15; return 8 * (i >> 2) + 4 * n + (i & 3); }

struct Unit { int pm, pn; };
struct Gemm { const bf16_t* A; const bf16_t* Bt; int M, N, K; };
struct StaticOrder {
    int nM, nN, nwg, G, c;
    __host__ __device__ void init(int M, int N, int G_, int c_) { nM = M / BM; nN = N / BM; nwg = nM * nN; G = G_; c = c_; }
    __host__ __device__ bool next(int i, Unit& u) const {
        const long L = (long)i * G + c; if (L >= nwg) return false;
        int wgid = (int)L; { const int q = nwg / NXCD, r = nwg % NXCD, xcd = wgid % NXCD, off = wgid / NXCD; wgid = (xcd < r ? xcd * (q + 1) : r * (q + 1) + (xcd - r) * q) + off; }
        const int nig = WGM * nN, gid = wgid / nig, fm = gid * WGM, gsz = (nM - fm) < WGM ? (nM - fm) : WGM;
        u.pm = fm + ((wgid % nig) % gsz); u.pn = (wgid % nig) / gsz; return true;
    }
    __device__ __forceinline__ void a_ready(const Unit&) const {}
    __device__ __forceinline__ void done(const Unit&) const {}
};
__device__ __forceinline__ unsigned cvt_pk_bf16(float lo, float hi) { unsigned r; asm volatile("v_cvt_pk_bf16_f32 %0, %1, %2" : "=v"(r) : "v"(lo), "v"(hi)); return r; }
typedef float f32x2 __attribute__((ext_vector_type(2)));
template <class Epi, class Sched, bool ALIGN_EPI = false, bool SP2 = false>
__device__ __forceinline__ void gemm_phase(PG8_LAS unsigned char* lds, const Gemm g, const Sched& S, const Epi& E) {
    int tid_ = tid_rebuilt(); asm volatile("" : "+v"(tid_));
    const int tid = tid_, wid = __builtin_amdgcn_readfirstlane(tid >> 6), lane = tid & 63, wr = wid >> 2, wc = wid & 3, fr = lane & 15, fq = lane >> 4;
    int K_ = g.K; asm volatile("" : "+s"(K_));
    const int K = K_, nt = K / BK;
    unsigned voffA[2], voffB[2];
#pragma unroll
    for (int i = 0; i < 2; ++i) { int R, C; stage_rc(tid * 16 + i * 8192, R, C); const int Rb = Epi::PERM ? ((R & ~31) + perm32(R & 31)) : R;
        voffA[i] = (unsigned)(R * K + C) * 2u; voffB[i] = (unsigned)(Rb * K + C) * 2u; }
    const size_t kstep = (size_t)(BK * 2);
    const size_t hstep = (size_t)HALF * K * 2;
    const size_t tstep = 2 * hstep;
    const unsigned ldsw = (unsigned)wid * 1024u;
    const int aoff = lds_byte(wr * 64 + fr, fq * 8), boff = lds_byte(wc * 32 + fr, fq * 8);
#define PG8_SA(b, h) (((b) * 2 + (h)) * HTB)
#define PG8_SB(b, h) ((4 + (b) * 2 + (h)) * HTB)
#define PG8_STAGE(bufoff, gbase, voff) do { _Pragma("unroll") for (int _i = 0; _i < 2; ++_i) \
        __builtin_amdgcn_global_load_lds((const unsigned*)((const char*)(gbase) + (voff)[_i]), (PG8_LAS unsigned*)(lds + (bufoff) + ldsw + _i * 8192), 16, 0, 0); } while (0)
#define PG8_LDA(dst, b, h) do { _Pragma("unroll") for (int m = 0; m < 4; ++m) _Pragma("unroll") for (int k = 0; k < 2; ++k) dst[m][k] = *(const PG8_LAS bf16x8*)(lds + PG8_SA(b, h) + aoff + m * 2048 + k * 1024); } while (0)
#define PG8_LDB(dst, b, h) do { _Pragma("unroll") for (int n = 0; n < 2; ++n) _Pragma("unroll") for (int k = 0; k < 2; ++k) dst[n][k] = *(const PG8_LAS bf16x8*)(lds + PG8_SB(b, h) + boff + n * 2048 + k * 1024); } while (0)
#define PG8_MMA(ai, bj, At, Bt) do { __builtin_amdgcn_s_setprio(1); _Pragma("unroll") for (int m = 0; m < 4; ++m) _Pragma("unroll") for (int n = 0; n < 2; ++n) _Pragma("unroll") for (int k = 0; k < 2; ++k) \
        acc[ai][bj][m][n] = __builtin_amdgcn_mfma_f32_16x16x32_bf16(Bt[n][k], At[m][k], acc[ai][bj][m][n], 0, 0, 0); __builtin_amdgcn_s_setprio(0); } while (0)
#define PG8_WAIT_V(n) asm volatile("s_waitcnt vmcnt(" #n ")" ::: "memory")
#define PG8_WAIT_L(n) asm volatile("s_waitcnt lgkmcnt(" #n ")" ::: "memory")
#define PG8_BAR __builtin_amdgcn_s_barrier()
#define PG8_SCHED __builtin_amdgcn_sched_barrier(0)
    Unit cur, nxt; int ui = 0;
    if (!S.next(0, cur)) return;
    f32x4 acc[2][2][4][2];
#pragma unroll
    for (int a = 0; a < 2; ++a)
#pragma unroll
        for (int b = 0; b < 2; ++b)
#pragma unroll
            for (int m = 0; m < 4; ++m)
#pragma unroll
                for (int n = 0; n < 2; ++n) acc[a][b][m][n] = (f32x4){0.f, 0.f, 0.f, 0.f};
    bf16x8 At[4][2], B0[2][2], B1[2][2];
    const char* cA = (const char*)g.A + (size_t)cur.pm * tstep; const char* cB = (const char*)g.Bt + (size_t)cur.pn * tstep;
    S.a_ready(cur);
    if constexpr (SP2) {
        PG8_STAGE(PG8_SB(0, 0), cB, voffB); PG8_STAGE(PG8_SB(0, 1), cB + hstep, voffB); PG8_STAGE(PG8_SA(0, 0), cA, voffA); PG8_STAGE(PG8_SA(0, 1), cA + hstep, voffA);
        if (wr == 1) PG8_BAR;
        PG8_WAIT_V(2); PG8_BAR;
        PG8_STAGE(PG8_SB(1, 0), cB + kstep, voffB); PG8_STAGE(PG8_SA(1, 0), cA + kstep, voffA); PG8_STAGE(PG8_SB(1, 1), cB + hstep + kstep, voffB);
        PG8_WAIT_V(6); PG8_BAR;
    } else {
        PG8_STAGE(PG8_SB(0, 0), cB, voffB); PG8_STAGE(PG8_SA(0, 0), cA, voffA); PG8_STAGE(PG8_SB(0, 1), cB + hstep, voffB); PG8_STAGE(PG8_SA(0, 1), cA + hstep, voffA);
        if (wr == 1) PG8_BAR;
        PG8_WAIT_V(4); PG8_BAR;
        PG8_STAGE(PG8_SB(1, 0), cB + kstep, voffB); PG8_STAGE(PG8_SA(1, 0), cA + kstep, voffA); PG8_STAGE(PG8_SB(1, 1), cB + hstep + kstep, voffB);
        PG8_WAIT_V(6); PG8_BAR;
    }
    for (;;) {
        const bool has_next = S.next(ui + 1, nxt);
        const char* nA = has_next ? (const char*)g.A + (size_t)nxt.pm * tstep : cA; const char* nB = has_next ? (const char*)g.Bt + (size_t)nxt.pn * tstep : cB;
        for (int t = 0; t < nt; t += 2) {
            const bool last = (t == nt - 2);
            const char* a1 = cA + (size_t)(t + 1) * kstep;
            const char* a2 = last ? nA : cA + (size_t)(t + 2) * kstep; const char* b2 = last ? nB : cB + (size_t)(t + 2) * kstep;
            const char* a3 = a2 + kstep; const char* b3 = b2 + kstep;
            if (last && has_next) S.a_ready(nxt);
            if constexpr (SP2) {
            PG8_LDB(B0, 0, 0); PG8_LDB(B1, 0, 1); PG8_SCHED; PG8_LDA(At, 0, 0); PG8_STAGE(PG8_SA(1, 1), a1 + hstep, voffA);
            PG8_WAIT_V(8); PG8_WAIT_L(0); PG8_BAR; PG8_MMA(0, 0, At, B0); PG8_MMA(0, 1, At, B1); PG8_BAR; PG8_SCHED;
            PG8_LDA(At, 0, 1); PG8_STAGE(PG8_SB(0, 0), b2, voffB); PG8_STAGE(PG8_SB(0, 1), b2 + hstep, voffB); PG8_STAGE(PG8_SA(0, 0), a2, voffA);
            PG8_WAIT_V(8); PG8_WAIT_L(0); PG8_BAR; PG8_MMA(1, 0, At, B0); PG8_MMA(1, 1, At, B1); PG8_BAR; PG8_SCHED;
            PG8_LDB(B0, 1, 0); PG8_LDB(B1, 1, 1); PG8_SCHED; PG8_LDA(At, 1, 0); PG8_STAGE(PG8_SA(0, 1), a2 + hstep, voffA);
            PG8_WAIT_V(8); PG8_WAIT_L(0); PG8_BAR; PG8_MMA(0, 0, At, B0); PG8_MMA(0, 1, At, B1); PG8_BAR; PG8_SCHED;
            PG8_LDA(At, 1, 1); PG8_STAGE(PG8_SB(1, 0), b3, voffB); PG8_STAGE(PG8_SB(1, 1), b3 + hstep, voffB); PG8_STAGE(PG8_SA(1, 0), a3, voffA);
            PG8_WAIT_V(8); PG8_WAIT_L(0); PG8_BAR; PG8_MMA(1, 0, At, B0); PG8_MMA(1, 1, At, B1); PG8_BAR; PG8_SCHED;
            } else {
            PG8_LDB(B0, 0, 0); PG8_SCHED; PG8_LDA(At, 0, 0); PG8_STAGE(PG8_SA(1, 1), a1 + hstep, voffA);
            PG8_WAIT_L(8); PG8_BAR; PG8_WAIT_L(0); PG8_MMA(0, 0, At, B0); PG8_BAR; PG8_SCHED;
            PG8_LDB(B1, 0, 1); PG8_STAGE(PG8_SB(0, 0), b2, voffB);
            PG8_BAR; PG8_WAIT_L(0); PG8_MMA(0, 1, At, B1); PG8_BAR;
            PG8_LDA(At, 0, 1); PG8_STAGE(PG8_SA(0, 0), a2, voffA);
            PG8_BAR; PG8_WAIT_L(0); PG8_MMA(1, 0, At, B0); PG8_BAR; PG8_SCHED;
            PG8_STAGE(PG8_SB(0, 1), b2 + hstep, voffB);
            PG8_WAIT_V(6); PG8_BAR; PG8_MMA(1, 1, At, B1); PG8_BAR;
            PG8_LDB(B0, 1, 0); PG8_SCHED; PG8_LDA(At, 1, 0); PG8_STAGE(PG8_SA(0, 1), a2 + hstep, voffA);
            PG8_WAIT_L(8); PG8_BAR; PG8_WAIT_L(0); PG8_MMA(0, 0, At, B0); PG8_BAR; PG8_SCHED;
            PG8_LDB(B1, 1, 1); PG8_STAGE(PG8_SB(1, 0), b3, voffB);
            PG8_BAR; PG8_WAIT_L(0); PG8_MMA(0, 1, At, B1); PG8_BAR;
            PG8_LDA(At, 1, 1); PG8_STAGE(PG8_SA(1, 0), a3, voffA);
            PG8_BAR; PG8_WAIT_L(0); PG8_MMA(1, 0, At, B0); PG8_BAR; PG8_SCHED;
            PG8_STAGE(PG8_SB(1, 1), b3 + hstep, voffB);
            PG8_WAIT_V(6); PG8_BAR; PG8_MMA(1, 1, At, B1); PG8_BAR;
            }
        }
        if constexpr (ALIGN_EPI) { if (wr == 0) PG8_BAR; }
        if constexpr (!Epi::AFTER_DRAIN) { E(acc, cur, wr, wc, fr, fq); S.done(cur); }
        if (!has_next) break;
#pragma unroll
        for (int a = 0; a < 2; ++a)
#pragma unroll
            for (int b = 0; b < 2; ++b)
#pragma unroll
                for (int m = 0; m < 4; ++m)
#pragma unroll
                    for (int n = 0; n < 2; ++n) acc[a][b][m][n] = (f32x4){0.f, 0.f, 0.f, 0.f};
        cur = nxt; cA = nA; cB = nB; ++ui;
        if constexpr (ALIGN_EPI) { if (wr == 1) PG8_BAR; }
    }
    PG8_WAIT_V(0);
    if constexpr (!ALIGN_EPI) { if (wr == 0) PG8_BAR; }
    PG8_BAR;
    if constexpr (Epi::AFTER_DRAIN) { E.fused(acc, cur, wr, wc, fr, fq, lds, wid, lane); S.done(cur); }
#undef PG8_SA
#undef PG8_SB
#undef PG8_STAGE
#undef PG8_LDA
#undef PG8_LDB
#undef PG8_MMA
#undef PG8_WAIT_V
#undef PG8_WAIT_L
#undef PG8_BAR
#undef PG8_SCHED
}
}
namespace pg8 {
struct ExtOrder : StaticOrder {
    int n_extra, pm0, pn_extra;
    __device__ __forceinline__ void init2(int M, int N, int G_, int c_, int n_extra_, int pm0_, int pn_extra_) { init(M, N, G_, c_); n_extra = n_extra_; pm0 = pm0_; pn_extra = pn_extra_; }
    __device__ __forceinline__ bool next(int i, Unit& u) const {
        const long L = (long)i * G + c; if (L < nwg) return StaticOrder::next(i, u);
        const long e = L - nwg; if (e >= n_extra) return false; u.pm = pm0 + (int)e; u.pn = pn_extra; return true;
    }
};
typedef unsigned u32x2 __attribute__((ext_vector_type(2)));
__device__ __forceinline__ f32x2 gelu_pk(f32x2 v) {
    const f32x2 av = __builtin_elementwise_abs(v), d = av * 0.2316418882f + 1.0f;
    f32x2 t; t.x = __builtin_amdgcn_rcpf(d.x); t.y = __builtin_amdgcn_rcpf(d.y);
    f32x2 q = t * 0.5307027145f + (-0.7265760135f); q = q * t + 0.7107068705f; q = q * t + (-0.142248368f); q = q * t + 0.127414796f; q = q * t;
    const f32x2 s = (v * v) * (-0.72134752044f);
    f32x2 e; e.x = __builtin_amdgcn_exp2f(s.x); e.y = __builtin_amdgcn_exp2f(s.y);
    const f32x2 m = v * (q * e), r = v - m;
    f32x2 o; o.x = v.x < 0.f ? m.x : r.x; o.y = v.y < 0.f ? m.y : r.y; return o;
}
__device__ __forceinline__ f32x4 gelu4(f32x4 v) { f32x2 a = gelu_pk((f32x2){v[0], v[1]}), b = gelu_pk((f32x2){v[2], v[3]}); return (f32x4){a.x, a.y, b.x, b.y}; }
__device__ __forceinline__ float silu1(float v) { return v * __builtin_amdgcn_rcpf(1.0f + __builtin_amdgcn_exp2f(-1.4426950408889634f * v)); }
__device__ __forceinline__ f32x4 silu4(f32x4 v) { return (f32x4){silu1(v[0]), silu1(v[1]), silu1(v[2]), silu1(v[3])}; }
__device__ __forceinline__ u32x2 pk4(f32x4 v) { u32x2 w; w.x = cvt_pk_bf16(v[0], v[1]); w.y = cvt_pk_bf16(v[2], v[3]); return w; }
__device__ __forceinline__ void rope4(f32x4& v0, f32x4& v1, const float* cs) {
    const f32x4 a = *(const f32x4*)cs, b = *(const f32x4*)(cs + 4);
    const f32x4 co = {a[0], a[2], b[0], b[2]}, si = {a[1], a[3], b[1], b[3]};
    const f32x4 o0 = v0 * co - v1 * si, o1 = v0 * si + v1 * co; v0 = o0; v1 = o1;
}

struct EpiIn0 {
    static constexpr bool PERM = false, AFTER_DRAIN = false;
    bf16_t* P0; const float* rope0; float* vvp;
    __device__ __forceinline__ void operator()(const f32x4 (&acc)[2][2][4][2], const Unit& u, int wr, int wc, int fr, int fq) const {
        const int row0 = u.pm * BM + wr * 64 + fr, pn = u.pn, colw = pn * BM + wc * 32 + 4 * fq;
        const bool latent = u.pm * BM < LROWS;
        if (pn <= 2) {
#pragma unroll
            for (int ai = 0; ai < 2; ++ai)
#pragma unroll
                for (int m = 0; m < 4; ++m) { const int row = row0 + ai * HALF + m * 16; const float* cs = rope0 + ((size_t)(row % SEQ) * 32 + (wc & 1) * 16 + 4 * fq) * 2;
                    bf16_t* rp = P0 + (size_t)row * N_IN0 + colw;
#pragma unroll
                    for (int bj = 0; bj < 2; ++bj) { f32x4 v0 = acc[ai][bj][m][0], v1 = acc[ai][bj][m][1];
                        if (!(pn == 2 && bj == 1)) { if (latent) rope4(v0, v1, cs); if (pn < 2) { v0 = v0 * QSCALE0; v1 = v1 * QSCALE0; } }
                        *(u32x2*)(rp + bj * HALF) = pk4(v0); *(u32x2*)(rp + bj * HALF + 16) = pk4(v1); }
                    asm volatile("" ::: "memory"); }
        } else if (pn <= 6) {
#pragma unroll
            for (int ai = 0; ai < 2; ++ai)
#pragma unroll
                for (int m = 0; m < 4; ++m) { const int row = row0 + ai * HALF + m * 16; bf16_t* rp = P0 + (size_t)row * N_IN0 + colw; float s = 0.f, q = 0.f;
#pragma unroll
                    for (int bj = 0; bj < 2; ++bj) { const f32x4 v0 = gelu4(acc[ai][bj][m][0]), v1 = gelu4(acc[ai][bj][m][1]);
                        s += (v0[0] + v0[1]) + (v0[2] + v0[3]) + (v1[0] + v1[1]) + (v1[2] + v1[3]);
                        q += (v0[0] * v0[0] + v0[1] * v0[1]) + (v0[2] * v0[2] + v0[3] * v0[3]) + (v1[0] * v1[0] + v1[1] * v1[1]) + (v1[2] * v1[2] + v1[3] * v1[3]);
                        *(u32x2*)(rp + bj * HALF) = pk4(v0); *(u32x2*)(rp + bj * HALF + 16) = pk4(v1); }
                    if (pn >= 5) { s += xshfl<16>(s); s = xsum32(s); q += xshfl<16>(q); q = xsum32(q);
                        if (fq == 0) *(f32x2*)(vvp + ((size_t)row * 8 + (pn - 5) * 4 + wc) * 2) = (f32x2){s, q}; } }
        } else {
#pragma unroll
            for (int ai = 0; ai < 2; ++ai)
#pragma unroll
                for (int m = 0; m < 4; ++m) { const int row = row0 + ai * HALF + m * 16; bf16_t* rp = P0 + (size_t)row * N_IN0 + colw;
#pragma unroll
                    for (int bj = 0; bj < 2; ++bj) { *(u32x2*)(rp + bj * HALF) = pk4(silu4(acc[ai][bj][m][0])); *(u32x2*)(rp + bj * HALF + 16) = pk4(silu4(acc[ai][bj][m][1])); } }
        }
    }
};
struct EpiOut {
    static constexpr bool PERM = false, AFTER_DRAIN = false;
    const float* res; float* dst; const float* resc; float* dstc; const float* mod;
    __device__ __forceinline__ void operator()(const f32x4 (&acc)[2][2][4][2], const Unit& u, int wr, int wc, int fr, int fq) const {
        const bool latent = u.pm * BM < LROWS; const int rbase = latent ? u.pm * BM : u.pm * BM - LROWS; const int mr = latent ? (u.pm * BM) / SEQ : 8;
        const float* rs = latent ? res : resc; float* ds = latent ? dst : dstc;
        const int row0 = rbase + wr * 64 + fr, col0 = u.pn * BM + wc * 32 + 4 * fq;
        f32x4 g[2][2];
#pragma unroll
        for (int bj = 0; bj < 2; ++bj)
#pragma unroll
            for (int n = 0; n < 2; ++n) g[bj][n] = *(const f32x4*)(mod + (size_t)mr * 3072 + 2048 + col0 + bj * HALF + n * 16);
#pragma unroll
        for (int ai = 0; ai < 2; ++ai)
#pragma unroll
            for (int m = 0; m < 4; ++m) { const size_t off = (size_t)(row0 + ai * HALF + m * 16) * DM + col0;
#pragma unroll
                for (int bj = 0; bj < 2; ++bj)
#pragma unroll
                    for (int n = 0; n < 2; ++n) { const f32x4 b = *(const f32x4*)(rs + off + bj * HALF + n * 16); *(f32x4*)(ds + off + bj * HALF + n * 16) = b + g[bj][n] * acc[ai][bj][m][n]; }
                if (m & 1) asm volatile("" ::: "memory"); }
    }
};
struct EpiIn1 {
    static constexpr bool PERM = false, AFTER_DRAIN = false;
    bf16_t *QA, *KVA, *KPE, *G1; float *qsp, *kvsp; const float* rope1;
    __device__ __forceinline__ void operator()(const f32x4 (&acc)[2][2][4][2], const Unit& u, int wr, int wc, int fr, int fq) const {
        const int row0 = u.pm * BM + wr * 64 + fr, pn = u.pn, cw = wc * 32 + 4 * fq; const bool latent = u.pm * BM < LROWS;
#pragma unroll
        for (int ai = 0; ai < 2; ++ai)
#pragma unroll
            for (int m = 0; m < 4; ++m) { const int row = row0 + ai * HALF + m * 16;
                if (pn == 0) { float q = 0.f; bf16_t* rp = QA + (size_t)row * 256 + cw;
#pragma unroll
                    for (int bj = 0; bj < 2; ++bj) { const f32x4 v0 = acc[ai][bj][m][0], v1 = acc[ai][bj][m][1];
                        q += (v0[0] * v0[0] + v0[1] * v0[1]) + (v0[2] * v0[2] + v0[3] * v0[3]) + (v1[0] * v1[0] + v1[1] * v1[1]) + (v1[2] * v1[2] + v1[3] * v1[3]);
                        *(u32x2*)(rp + bj * HALF) = pk4(v0); *(u32x2*)(rp + bj * HALF + 16) = pk4(v1); }
                    q += xshfl<16>(q); q = xsum32(q); if (fq == 0) qsp[(size_t)row * 4 + wc] = q;
                } else if (pn == 1) { bf16_t* rp = KVA + (size_t)row * 256 + cw;
                    { const f32x4 v0 = acc[ai][0][m][0], v1 = acc[ai][0][m][1];
                      float q = (v0[0] * v0[0] + v0[1] * v0[1]) + (v0[2] * v0[2] + v0[3] * v0[3]) + (v1[0] * v1[0] + v1[1] * v1[1]) + (v1[2] * v1[2] + v1[3] * v1[3]);
                      *(u32x2*)(rp) = pk4(v0); *(u32x2*)(rp + 16) = pk4(v1);
                      q += xshfl<16>(q); q = xsum32(q); if (fq == 0) kvsp[(size_t)row * 4 + wc] = q; }
                    *(u32x2*)(rp + HALF) = (u32x2){0u, 0u}; *(u32x2*)(rp + HALF + 16) = (u32x2){0u, 0u};
                    if (wc == 0) { f32x4 v0 = acc[ai][1][m][0], v1 = acc[ai][1][m][1];
                        if (latent) rope4(v0, v1, rope1 + ((size_t)(row % SEQ) * 16 + 4 * fq) * 2);
                        bf16_t* kp = KPE + (size_t)row * 32 + 4 * fq; *(u32x2*)(kp) = pk4(v0); *(u32x2*)(kp + 16) = pk4(v1); }
                } else { bf16_t* rp = G1 + (size_t)row * DM + (pn - 2) * BM + cw;
#pragma unroll
                    for (int bj = 0; bj < 2; ++bj) { *(u32x2*)(rp + bj * HALF) = pk4(silu4(acc[ai][bj][m][0])); *(u32x2*)(rp + bj * HALF + 16) = pk4(silu4(acc[ai][bj][m][1])); } }
                asm volatile("" ::: "memory");
            }
    }
};
struct EpiQb {
    static constexpr bool PERM = false, AFTER_DRAIN = false;
    bf16_t* Q1; const float* qsp; const float* rope1;
    __device__ __forceinline__ void operator()(const f32x4 (&acc)[2][2][4][2], const Unit& u, int wr, int wc, int fr, int fq) const {
        const int row0 = u.pm * BM + wr * 64 + fr, colw = u.pn * BM + wc * 32 + 4 * fq;
#pragma unroll
        for (int ai = 0; ai < 2; ++ai)
#pragma unroll
            for (int m = 0; m < 4; ++m) { const int row = row0 + ai * HALF + m * 16; const f32x4 sp = *(const f32x4*)(qsp + (size_t)row * 4);
                const float sc = QSCALE1 * __builtin_amdgcn_rsqf(((sp[0] + sp[1]) + (sp[2] + sp[3])) * (1.0f / 256) + NORM_EPS);
                bf16_t* rp = Q1 + (size_t)row * 1536 + colw;
#pragma unroll
                for (int bj = 0; bj < 2; ++bj) { f32x4 v0 = acc[ai][bj][m][0] * sc, v1 = acc[ai][bj][m][1] * sc; const int g32 = u.pn * 8 + bj * 4 + wc;
                    if (g32 % 3 == 2) rope4(v0, v1, rope1 + ((size_t)(row % SEQ) * 16 + 4 * fq) * 2);
                    *(u32x2*)(rp + bj * HALF) = pk4(v0); *(u32x2*)(rp + bj * HALF + 16) = pk4(v1); }
                asm volatile("" ::: "memory"); }
    }
};
struct EpiKvb {
    static constexpr bool PERM = false, AFTER_DRAIN = false;
    bf16_t *K1N, *V1; const float* kvsp;
    __device__ __forceinline__ void operator()(const f32x4 (&acc)[2][2][4][2], const Unit& u, int wr, int wc, int fr, int fq) const {
        const int row0 = u.pm * BM + wr * 64 + fr, colw = (u.pn & 3) * BM + wc * 32 + 4 * fq; bf16_t* dst = u.pn < 4 ? K1N : V1;
#pragma unroll
        for (int ai = 0; ai < 2; ++ai)
#pragma unroll
            for (int m = 0; m < 4; ++m) { const int row = row0 + ai * HALF + m * 16; const f32x4 sp = *(const f32x4*)(kvsp + (size_t)row * 4);
                const float sc = __builtin_amdgcn_rsqf(((sp[0] + sp[1]) + (sp[2] + sp[3])) * (1.0f / 128) + NORM_EPS);
                bf16_t* rp = dst + (size_t)row * DM + colw;
#pragma unroll
                for (int bj = 0; bj < 2; ++bj) { *(u32x2*)(rp + bj * HALF) = pk4(acc[ai][bj][m][0] * sc); *(u32x2*)(rp + bj * HALF + 16) = pk4(acc[ai][bj][m][1] * sc); }
                asm volatile("" ::: "memory"); }
    }
};
}
#ifndef ABL_NOQK
#define ABL_NOQK 0
#endif
#ifndef ABL_NOPV
#define ABL_NOPV 0
#endif
#ifndef ABL_NODMA
#define ABL_NODMA 0
#endif
#ifndef ABL_NOLDS
#define ABL_NOLDS 0
#endif
namespace att {
using bf16x8 = __attribute__((ext_vector_type(8))) short;
using s16x4 = __attribute__((ext_vector_type(4))) short;
using f32x16 = __attribute__((ext_vector_type(16))) float;
using u32x4 = __attribute__((ext_vector_type(4))) unsigned;
typedef float f32x2_t __attribute__((ext_vector_type(2))); typedef __bf16 bf16x2_t __attribute__((ext_vector_type(2)));
constexpr int NW = 8, QBLK = 32, QB = 256, KVBLK = 64, NSLOT = 4;
constexpr int KSLOT = 12288, VSLOT = 8192;
constexpr int LDS_K = 0, LDS_V = NSLOT * KSLOT, LDS_WS = LDS_V + NSLOT * VSLOT, LDS_OST = LDS_WS + NW * 64 * 4, LDS_BYTES = LDS_OST + NW * 4096;
constexpr float THR = 6.0f;
__device__ __forceinline__ int crow(int r, int hi) { return (r & 3) + 8 * (r >> 2) + 4 * hi; }
__device__ __forceinline__ void glds16(const void* gsrc, unsigned lds_dst) { unsigned keep;
    asm volatile("s_mov_b32 %0, m0\n\ts_mov_b32 m0, %2\n\ts_nop 0\n\tglobal_load_lds_dwordx4 %1, off\n\ts_mov_b32 m0, %0" : "=&s"(keep) : "v"(gsrc), "s"(lds_dst) : "memory"); }
__device__ __forceinline__ unsigned cvtpk(float lo, float hi) { f32x2_t v = {lo, hi}; bf16x2_t b = __builtin_convertvector(v, bf16x2_t); return __builtin_bit_cast(unsigned, b); }
#define ATT_WAIT_BAR(N) asm volatile("s_waitcnt vmcnt(" #N ") lgkmcnt(0)\n\ts_barrier" ::: "memory")
#define ATT_SBAR() __builtin_amdgcn_sched_barrier(0)
#ifdef ABL_NOEXP
#define ATT_EXP2(x) (x)
#else
#define ATT_EXP2(x) __builtin_amdgcn_exp2f(x)
#endif
#ifdef ABL_NOBAR
#undef ATT_WAIT_BAR
#define ATT_WAIT_BAR(N) asm volatile("s_waitcnt vmcnt(" #N ") lgkmcnt(0)" ::: "memory")
#endif

struct LayWin {
    static constexpr unsigned QB = WS_P0 + C_Q * 2, PQ = N_IN0 * 2, KB = WS_P0 + C_K * 2, PK = N_IN0 * 2, K2B = 0, PK2 = 0, VB = WS_P0 + C_V * 2, PV = N_IN0 * 2, GB = WS_P0 + C_G * 2, PG = N_IN0 * 2, OB = WS_MIX, PO = DM * 2;
};
struct LayMla {
    static constexpr unsigned QB = WS_Q1, PQ = 1536 * 2, KB = WS_K1N, PK = DM * 2, K2B = WS_KPE, PK2 = 64, VB = WS_V1, PV = DM * 2, GB = WS_G1, PG = DM * 2, OB = WS_MIX, PO = DM * 2;
};
struct Desc {
    const unsigned char* ws;
    int qh, kh, gh;
    int qrow0;
    int lat_row0, ntl;
    int ctx_row0, ntc;
    int band_q0, band_k0;
    float sink; int has_sink;
};
__device__ __forceinline__ void glds16s(const unsigned char* sbase, unsigned voff, unsigned lds_dst) { unsigned keep;
    asm volatile("s_mov_b32 %0, m0\n\ts_mov_b32 m0, %3\n\ts_nop 0\n\tglobal_load_lds_dwordx4 %1, %2\n\ts_mov_b32 m0, %0" : "=&s"(keep) : "v"(voff), "s"(sbase), "s"(lds_dst) : "memory"); }

template <class L, int ND0, bool WINDOWED, bool STAGGER>
__device__ __forceinline__ void unit(const Desc& D, char* shm) {
    constexpr int NCH = 2 * ND0, KPRE = STAGGER ? 1 : 2;
    int tid_ = tid_rebuilt(); asm volatile("" : "+v"(tid_));
    const int tid = tid_, lane = tid & 63, r32 = lane & 31, hi = lane >> 5; const int wid = __builtin_amdgcn_readfirstlane(tid >> 6);
    const unsigned lds0 = (unsigned)(uintptr_t)shm;
    float* wsf = (float*)(shm + LDS_WS) + wid * 64;
    const int NT = D.ntl + D.ntc;
    const int ch2 = 8 + (wid & 3);
    const unsigned kdst = lds0 + LDS_K + wid * 1024, kdst2 = lds0 + LDS_K + ch2 * 1024, vdst = lds0 + LDS_V + wid * 1024;
    const int vr = 16 * (wid & 3) + (lane >> 2), vc = (wid >> 2) * 32 + (lane & 3) * 8;
#define ATT_KROW0(t) ((t) < D.ntl ? D.lat_row0 + (t) * KVBLK : D.ctx_row0 + ((t) - D.ntl) * KVBLK)
    const unsigned kvo = (unsigned)lane * L::PK + (unsigned)wid * 16u, k2vo = (unsigned)lane * L::PK2 + (unsigned)(ch2 - 8) * 16u, vvo = (unsigned)vr * L::PV + (unsigned)vc * 2u;
#define ATT_DMA_K(t, slot) do { if (ABL_NODMA) break; const unsigned kr0_ = (unsigned)ATT_KROW0(t); \
        glds16s(D.ws + (L::KB + (unsigned)D.kh + kr0_ * L::PK), kvo, (unsigned)__builtin_amdgcn_readfirstlane(kdst + (slot) * KSLOT)); \
        if (NCH > 8 && wid < 4) glds16s(D.ws + (L::K2B + kr0_ * L::PK2), k2vo, (unsigned)__builtin_amdgcn_readfirstlane(kdst2 + (slot) * KSLOT)); } while (0)
#define ATT_DMA_V(t, slot) do { if (ABL_NODMA) break; const unsigned kr0_ = (unsigned)ATT_KROW0(t); \
        glds16s(D.ws + (L::VB + (unsigned)D.kh + kr0_ * L::PV), vvo, (unsigned)__builtin_amdgcn_readfirstlane(vdst + (slot) * VSLOT)); } while (0)
#define ATT_WAIT_TILE(ahead) do { if (NCH > 8 && wid < 4) { if ((ahead) == 2) ATT_WAIT_BAR(6); else if ((ahead) == 1) ATT_WAIT_BAR(3); else ATT_WAIT_BAR(0); } \
        else { if ((ahead) == 2) ATT_WAIT_BAR(4); else if ((ahead) == 1) ATT_WAIT_BAR(2); else ATT_WAIT_BAR(0); } } while (0)
    const bf16_t* Qw = (const bf16_t*)(D.ws + (L::QB + (unsigned)D.qh + (unsigned)(D.qrow0 + wid * QBLK + r32) * L::PQ));
    bf16x8 qr[ND0];
#pragma unroll
    for (int d0 = 0; d0 < ND0; ++d0) qr[d0] = *reinterpret_cast<const bf16x8*>(Qw + d0 * 16 + hi * 8);
    asm volatile("" ::: "memory");
    ATT_DMA_K(0, 0);
    if (NT > 1) ATT_DMA_K(1, 1);
    ATT_DMA_V(0, 0);
    if (NT > 2) ATT_DMA_K(2, 2);
    if (NT > 1) ATT_DMA_V(1, 1);
    const bool late = STAGGER && wid >= 4;
    float mhat = -1e4f, l_reg = 0.f; f32x16 o[2]; o[0] = f32x16{}; o[1] = f32x16{};
    const int qi = D.band_q0 + wid * QBLK + r32;
    const int qw0 = D.band_q0 + wid * QBLK;
    const int vb0 = (int)(lds0 + LDS_V) + ((lane >> 4) & 1) * 32 + (lane & 3) * 8 + (4 * hi + ((lane & 15) >> 2)) * 64;
    const char* kb0 = shm + LDS_K + hi * 1024 + r32 * 16;
#define ATT_MASK(P0, P1, tt) do { if (WINDOWED && (tt) < D.ntl) { const int jt_ = D.band_k0 + (tt) * KVBLK; \
        if (!((jt_ + 63 - qw0 <= 128) && (qw0 + 31 - jt_ <= 128))) { _Pragma("unroll") for (int r = 0; r < 16; ++r) { const int dd_ = jt_ + crow(r, hi) - qi; \
            if (dd_ > 128 || dd_ < -128) P0[r] = -1e30f; if (dd_ + 32 > 128 || dd_ + 32 < -128) P1[r] = -1e30f; } } } } while (0)
#define ATT_ROWMAX(P0, P1, RM) do { float a_ = fmaxf(fmaxf(P0[0], P0[1]), P1[0]), b_ = fmaxf(fmaxf(P0[2], P0[3]), P1[1]); a_ = fmaxf(fmaxf(a_, P1[2]), P1[3]); \
        _Pragma("unroll") for (int r = 4; r < 16; r += 4) { a_ = fmaxf(fmaxf(a_, P0[r]), P0[r + 1]); b_ = fmaxf(fmaxf(b_, P0[r + 2]), P0[r + 3]); a_ = fmaxf(fmaxf(a_, P1[r]), P1[r + 1]); b_ = fmaxf(fmaxf(b_, P1[r + 2]), P1[r + 3]); } \
        float m_ = fmaxf(a_, b_) - mhat; auto rr_ = __builtin_amdgcn_permlane32_swap(__float_as_uint(m_), __float_as_uint(m_), false, false); RM = fmaxf(__uint_as_float(rr_[0]), __uint_as_float(rr_[1])); } while (0)
#define ATT_QK_D0(N0, N1, kb_, d0) do { const bf16x8 b0_ = *reinterpret_cast<const bf16x8*>((kb_) + (d0) * 2048), b1_ = *reinterpret_cast<const bf16x8*>((kb_) + (d0) * 2048 + 512); \
        N0 = __builtin_amdgcn_mfma_f32_32x32x16_bf16(b0_, qr[d0], N0, 0, 0, 0); N1 = __builtin_amdgcn_mfma_f32_32x32x16_bf16(b1_, qr[d0], N1, 0, 0, 0); } while (0)
#define ATT_EXP1(P, r) do { P[r] = __builtin_amdgcn_exp2f(P[r] - mhat); sacc += P[r]; } while (0)
    int slot = 0;
    f32x16 pA0, pA1, pB0, pB1; float rm;
    if (NT > 2) { ATT_WAIT_TILE(2); } else { ATT_WAIT_TILE(0); }
    pA0 = f32x16{}; pA1 = f32x16{};
#pragma unroll
    for (int d0 = 0; d0 < ND0; ++d0) ATT_QK_D0(pA0, pA1, kb0, d0);
    ATT_MASK(pA0, pA1, 0); ATT_ROWMAX(pA0, pA1, rm);
#define ATT_PV(vs_, MID) do { const int vb_ = vb0 + (vs_) * VSLOT; \
        { s16x4 lo_[4], hh_[4]; \
          _Pragma("unroll") for (int ks = 0; ks < 4; ++ks) { \
                if (ABL_NOLDS) { lo_[ks] = __builtin_bit_cast(s16x4, (unsigned long long)ks * 0x3c003c003c003c00ull); } else asm volatile("ds_read_b64_tr_b16 %0,%1 offset:%c2" : "=&v"(lo_[ks]) : "v"(vb_), "i"(ks * 1024) : "memory"); \
                if (ABL_NOLDS) { hh_[ks] = __builtin_bit_cast(s16x4, (unsigned long long)(ks + 1) * 0x3c003c003c003c00ull); } else asm volatile("ds_read_b64_tr_b16 %0,%1 offset:%c2" : "=&v"(hh_[ks]) : "v"(vb_), "i"(ks * 1024 + 512) : "memory"); } \
          asm volatile("s_waitcnt lgkmcnt(0)" ::: "memory"); ATT_SBAR(); \
          _Pragma("unroll") for (int ks = 0; ks < 4; ++ks) { const bf16x8 vf_ = {lo_[ks][0], lo_[ks][1], lo_[ks][2], lo_[ks][3], hh_[ks][0], hh_[ks][1], hh_[ks][2], hh_[ks][3]}; \
            o[0] = __builtin_amdgcn_mfma_f32_32x32x16_bf16(pa[ks], vf_, o[0], 0, 0, 0); } } \
        MID; \
        { s16x4 lo_[4], hh_[4]; \
          _Pragma("unroll") for (int ks = 0; ks < 4; ++ks) { \
                if (ABL_NOLDS) { lo_[ks] = __builtin_bit_cast(s16x4, (unsigned long long)(ks + 2) * 0x3c003c003c003c00ull); } else asm volatile("ds_read_b64_tr_b16 %0,%1 offset:%c2" : "=&v"(lo_[ks]) : "v"(vb_), "i"(4096 + ks * 1024) : "memory"); \
                if (ABL_NOLDS) { hh_[ks] = __builtin_bit_cast(s16x4, (unsigned long long)(ks + 3) * 0x3c003c003c003c00ull); } else asm volatile("ds_read_b64_tr_b16 %0,%1 offset:%c2" : "=&v"(hh_[ks]) : "v"(vb_), "i"(4096 + ks * 1024 + 512) : "memory"); } \
          asm volatile("s_waitcnt lgkmcnt(0)" ::: "memory"); ATT_SBAR(); \
          _Pragma("unroll") for (int ks = 0; ks < 4; ++ks) { const bf16x8 vf_ = {lo_[ks][0], lo_[ks][1], lo_[ks][2], lo_[ks][3], hh_[ks][0], hh_[ks][1], hh_[ks][2], hh_[ks][3]}; \
            o[1] = __builtin_amdgcn_mfma_f32_32x32x16_bf16(pa[ks], vf_, o[1], 0, 0, 0); } } } while (0)
    bf16x8 pa[4] = {bf16x8{}, bf16x8{}, bf16x8{}, bf16x8{}};
#define ATT_STEP(C0, C1, N0, N1, t) do { \
          \
          \
        if ((t) + 3 < NT) { ATT_WAIT_TILE(1); } else { ATT_WAIT_TILE(0); } \
        if ((t) + 3 < NT) { ATT_DMA_K((t) + 3, (slot + 3) & 3); } \
        if ((t) + 2 < NT) { ATT_DMA_V((t) + 2, (slot + 2) & 3); } \
          \
        if (late && (t) > 0) { ATT_PV((slot + 3) & 3, do {} while (0)); } \
          \
        const int sn_ = (slot + 1) & 3; const char* kbn_ = kb0 + sn_ * KSLOT; bf16x8 kf_[2 * ND0]; \
        if (ABL_NOLDS) { _Pragma("unroll") for (int d0 = 0; d0 < ND0; ++d0) { kf_[2 * d0] = qr[d0]; kf_[2 * d0 + 1] = qr[ND0 - 1 - d0]; } } else \
        { _Pragma("unroll") for (int d0 = 0; d0 < KPRE; ++d0) { kf_[2 * d0] = *reinterpret_cast<const bf16x8*>(kbn_ + d0 * 2048); kf_[2 * d0 + 1] = *reinterpret_cast<const bf16x8*>(kbn_ + d0 * 2048 + 512); } } \
          \
        if (__any(rm > THR)) { const float dl_ = fmaxf(rm, 0.f); mhat += dl_; const float f_ = __builtin_amdgcn_exp2f(-dl_); l_reg *= f_; \
            if (hi == 0) wsf[r32] = f_; asm volatile("s_waitcnt lgkmcnt(0)" ::: "memory"); \
            _Pragma("unroll") for (int r = 0; r < 16; ++r) { const float fr_ = wsf[crow(r, hi)]; o[0][r] *= fr_; o[1][r] *= fr_; } } \
          \
        float sa0_ = 0.f, sa1_ = 0.f, sa2_ = 0.f, sa3_ = 0.f; \
        N0 = f32x16{}; N1 = f32x16{}; \
        ATT_SBAR(); \
        _Pragma("unroll") for (int g = 0; g < ND0; ++g) { \
            if (!ABL_NOLDS && g + KPRE < ND0) { kf_[2 * (g + KPRE)] = *reinterpret_cast<const bf16x8*>(kbn_ + (g + KPRE) * 2048); kf_[2 * (g + KPRE) + 1] = *reinterpret_cast<const bf16x8*>(kbn_ + (g + KPRE) * 2048 + 512); } \
            if (!ABL_NOQK) { N0 = __builtin_amdgcn_mfma_f32_32x32x16_bf16(kf_[2 * g], qr[g], N0, 0, 0, 0); N1 = __builtin_amdgcn_mfma_f32_32x32x16_bf16(kf_[2 * g + 1], qr[g], N1, 0, 0, 0); } \
            _Pragma("unroll") for (int r = (16 * g) / ND0; r < (16 * (g + 1)) / ND0; ++r) { C0[r] = ATT_EXP2(C0[r] - mhat); C1[r] = ATT_EXP2(C1[r] - mhat); \
                if (r & 1) { sa1_ += C0[r]; sa3_ += C1[r]; } else { sa0_ += C0[r]; sa2_ += C1[r]; } } \
            ATT_SBAR(); } \
        l_reg += (sa0_ + sa1_) + (sa2_ + sa3_); \
        { const u32x4 pw0_ = {cvtpk(C0[0], C0[1]), cvtpk(C0[2], C0[3]), cvtpk(C0[4], C0[5]), cvtpk(C0[6], C0[7])}; \
          const u32x4 pw1_ = {cvtpk(C0[8], C0[9]), cvtpk(C0[10], C0[11]), cvtpk(C0[12], C0[13]), cvtpk(C0[14], C0[15])}; \
          const u32x4 pw2_ = {cvtpk(C1[0], C1[1]), cvtpk(C1[2], C1[3]), cvtpk(C1[4], C1[5]), cvtpk(C1[6], C1[7])}; \
          const u32x4 pw3_ = {cvtpk(C1[8], C1[9]), cvtpk(C1[10], C1[11]), cvtpk(C1[12], C1[13]), cvtpk(C1[14], C1[15])}; \
          pa[0] = __builtin_bit_cast(bf16x8, pw0_); pa[1] = __builtin_bit_cast(bf16x8, pw1_); pa[2] = __builtin_bit_cast(bf16x8, pw2_); pa[3] = __builtin_bit_cast(bf16x8, pw3_); } \
          \
        if (!late) { ATT_PV(slot, do { ATT_MASK(N0, N1, (t) + 1); ATT_ROWMAX(N0, N1, rm); } while (0)); } \
        else { ATT_MASK(N0, N1, (t) + 1); ATT_ROWMAX(N0, N1, rm); } \
        slot = (slot + 1) & 3; } while (0)
    int t = 0;
    for (; t + 1 < NT; t += 2) { ATT_STEP(pA0, pA1, pB0, pB1, t); ATT_STEP(pB0, pB1, pA0, pA1, t + 1); }
    if (t < NT) { ATT_STEP(pA0, pA1, pB0, pB1, t); }
    if (late) { ATT_PV((slot + 3) & 3, do {} while (0)); }
    { auto rr = __builtin_amdgcn_permlane32_swap(__float_as_uint(l_reg), __float_as_uint(l_reg), false, false); l_reg = __uint_as_float(rr[0]) + __uint_as_float(rr[1]); }
    if (D.has_sink) l_reg += __builtin_amdgcn_exp2f(D.sink - mhat);
    if (hi == 0) wsf[32 + r32] = l_reg;
    asm volatile("s_waitcnt lgkmcnt(0)" ::: "memory");
    float rli[16];
#pragma unroll
    for (int r = 0; r < 16; ++r) rli[r] = __builtin_amdgcn_rcpf(wsf[32 + crow(r, hi)]);
    { __hip_bfloat16* stg = (__hip_bfloat16*)(shm + LDS_OST) + wid * 2048;
#pragma unroll
      for (int r = 0; r < 16; ++r) { const int orow = crow(r, hi);
#pragma unroll
          for (int d0 = 0; d0 < 2; ++d0) stg[orow * 64 + d0 * 32 + r32] = __float2bfloat16(o[d0][r] * rli[r]); }
      asm volatile("s_waitcnt lgkmcnt(0)" ::: "memory");
#pragma unroll
      for (int i = 0; i < 4; ++i) { const int row = i * 8 + (lane >> 3), c8 = (lane & 7) * 8; const unsigned grow = (unsigned)(D.qrow0 + wid * QBLK + row);
          const u32x4 ov = *(const u32x4*)(stg + row * 64 + c8); const u32x4 gv = *(const u32x4*)(D.ws + (L::GB + (unsigned)D.gh + grow * L::PG + c8 * 2)); u32x4 w;
#pragma unroll
          for (int k = 0; k < 4; ++k) { const float a0 = __uint_as_float(ov[k] << 16) * __uint_as_float(gv[k] << 16), a1 = __uint_as_float(ov[k] & 0xffff0000u) * __uint_as_float(gv[k] & 0xffff0000u); w[k] = cvtpk(a0, a1); }
          *(u32x4*)(const_cast<unsigned char*>(D.ws) + (L::OB + (unsigned)D.gh + grow * L::PO + c8 * 2)) = w; } }
    asm volatile("s_waitcnt vmcnt(0) lgkmcnt(0)\n\ts_barrier" ::: "memory");
#undef ATT_KROW0
#undef ATT_DMA_K
#undef ATT_DMA_V
#undef ATT_PV
#undef ATT_WAIT_TILE
#undef ATT_MASK
#undef ATT_ROWMAX
#undef ATT_QK_D0
#undef ATT_EXP1
#undef ATT_STEP
}
}
namespace thin {
#define TH_LAS __attribute__((address_space(3)))
typedef float f32x4 __attribute__((ext_vector_type(4)));
typedef float f32x2 __attribute__((ext_vector_type(2)));
typedef float f32x16 __attribute__((ext_vector_type(16)));
typedef unsigned u32x4 __attribute__((ext_vector_type(4)));
typedef unsigned u32x2 __attribute__((ext_vector_type(2)));
typedef short bf16x8 __attribute__((ext_vector_type(8)));
__device__ __forceinline__ unsigned pk2(float lo, float hi) { return (unsigned)f2bf(lo) | ((unsigned)f2bf(hi) << 16); }
__device__ __forceinline__ float wave_sum(float v) {
    v += xshfl<1>(v); v += xshfl<2>(v); v += xshfl<4>(v); v += xshfl<8>(v); v += xshfl<16>(v);
    return xsum32(v);
}
struct MapId { __device__ __forceinline__ int operator()(int n) const { return n; } };
struct MapIn1 { __device__ __forceinline__ int operator()(int n) const { return n < 384 ? n : (n < 416 ? 384 + pe_orig(n - 384) : (n < 512 ? -1 : n - 96)); } };
struct MapQb { __device__ __forceinline__ int operator()(int n) const { const int h = n / 96, w = n % 96; return h * 96 + (w < 64 ? w : 64 + pe_orig(w - 64)); } };
struct MapKvb { __device__ __forceinline__ int operator()(int n) const { const int nn = n & 1023; return (nn >> 6) * 128 + (nn & 63) + (n >= 1024 ? 64 : 0); } };
template <class MAP>
__device__ __forceinline__ void wcopy_item(const float* W, int Ksrc, int ldw, bf16_t* WT, int ldt, const float* scale, TH_LAS float* scr, int item, int nblk, int lane, MAP map) {
    const int kb = item / nblk, nb = item % nblk, k0 = 64 * kb, n0 = 32 * nb;
    const int sc = map(n0 + (lane & 31));
#pragma unroll 8
    for (int i = 0; i < 32; ++i) { const int kk = 2 * i + (lane >> 5); float v = 0.f;
        if (sc >= 0 && k0 + kk < Ksrc) { v = W[(size_t)(k0 + kk) * ldw + sc]; if (scale) v *= scale[k0 + kk]; }
        scr[kk * 33 + (lane & 31)] = v; }
    asm volatile("s_waitcnt lgkmcnt(0)" ::: "memory");
    const int c = lane & 7;
#pragma unroll
    for (int j = 0; j < 4; ++j) { const int n = (lane >> 3) + 8 * j; const TH_LAS float* s = scr + (8 * c) * 33 + n;
        u32x4 o; o.x = pk2(s[0 * 33], s[1 * 33]); o.y = pk2(s[2 * 33], s[3 * 33]); o.z = pk2(s[4 * 33], s[5 * 33]); o.w = pk2(s[6 * 33], s[7 * 33]);
        *(u32x4*)(WT + (size_t)(n0 + n) * ldt + k0 + 8 * c) = o; }
    asm volatile("s_waitcnt lgkmcnt(0)" ::: "memory");
}
constexpr int WI_IN0 = 16 * 88, WI_OUT0 = 16 * 32, WI_IN1 = 16 * 48, WI_QB = 4 * 48, WI_KVB = 4 * 64, WI_OUT1 = 16 * 32, WI_WS = 64  ;
constexpr int WI_ROPE = (SEQ * 48 + 63) / 64, WI_ADA = 2 * 12 * 32;
constexpr int WI_TOTAL = WI_IN0 + WI_OUT0 + WI_IN1 + WI_QB + WI_KVB + WI_OUT1 + WI_WS + WI_ROPE + WI_ADA;
__device__ __forceinline__ void stage0_item(const Params& p, int it, TH_LAS float* scr, int lane) {
    if (it < WI_ADA) {
        const int l = it / (12 * 32), nb = (it / 32) % 12, ks = it % 32, n = nb * 256 + lane * 4;
        f32x4 acc[9];
#pragma unroll
        for (int r = 0; r < 9; ++r) acc[r] = (f32x4){0.f, 0.f, 0.f, 0.f};
        const float* w = p.w_ada + (size_t)l * DM * 3072 + n;
#pragma unroll 4
        for (int k = ks * 32; k < ks * 32 + 32; ++k) { const f32x4 wv = *(const f32x4*)(w + (size_t)k * 3072);
#pragma unroll
            for (int r = 0; r < 9; ++r) { const float cv = r < 8 ? p.c[r * DM + k] : p.c_ctx[k]; acc[r] += wv * (cv * __builtin_amdgcn_rcpf(1.0f + __expf(-cv))); } }
        if (ks == 0) { const f32x4 bb = *(const f32x4*)(p.b_ada + l * 3072 + n);
#pragma unroll
            for (int r = 0; r < 9; ++r) acc[r] += bb; }
        float* md = WSP(float, WS_MOD) + (size_t)l * 9 * 3072 + n;
#pragma unroll
        for (int r = 0; r < 9; ++r)
#pragma unroll
            for (int i = 0; i < 4; ++i) atomicAdd(md + (size_t)r * 3072 + i, acc[r][i]);
        return; } it -= WI_ADA;
    if (it < WI_IN0) { wcopy_item(p.w_in0, DM, N_IN0, WSP(bf16_t, WS_WIN0), DM, nullptr, scr, it, 88, lane, MapId()); return; } it -= WI_IN0;
    if (it < WI_OUT0) { wcopy_item(p.w_out0, DM, DM, WSP(bf16_t, WS_WOUT0), DM, nullptr, scr, it, 32, lane, MapId()); return; } it -= WI_OUT0;
    if (it < WI_IN1) { wcopy_item(p.w_in1, DM, 1440, WSP(bf16_t, WS_WIN1), DM, nullptr, scr, it, 48, lane, MapIn1()); return; } it -= WI_IN1;
    if (it < WI_QB) { wcopy_item(p.w_qb, 256, 1536, WSP(bf16_t, WS_WQB), 256, p.q_norm, scr, it, 48, lane, MapQb()); return; } it -= WI_QB;
    if (it < WI_KVB) { wcopy_item(p.w_kvb, 128, 2048, WSP(bf16_t, WS_WKVB), 256, p.kv_norm, scr, it, 64, lane, MapKvb()); return; } it -= WI_KVB;
    if (it < WI_OUT1) { wcopy_item(p.w_out1, DM, DM, WSP(bf16_t, WS_WOUT1), DM, nullptr, scr, it, 32, lane, MapId()); return; } it -= WI_OUT1;
    if (it < WI_WS) { const size_t base = (size_t)it * 2048 + lane * 4;
#pragma unroll
        for (int j = 0; j < 8; ++j) { const f32x4 v = *(const f32x4*)(p.gm_ws + base + j * 256); *(u32x2*)(WSP(bf16_t, WS_WS) + base + j * 256) = (u32x2){pk2(v[0], v[1]), pk2(v[2], v[3])}; }
        return; } it -= WI_WS;
    { const long e = (long)it * 64 + lane; if (e < ROPE_ITEMS) nk_rope(p, e); }
}
__device__ __forceinline__ void modnorm_row(const Params& p, long r, int layer, int lane) {
    const float* src; int mr;
    if (r < LROWS) { src = (layer == 0 ? p.x : p.out) + (size_t)r * DM; mr = (int)(r / SEQ); }
    else { src = (layer == 0 ? p.ctx : WSP(float, WS_X1C)) + (size_t)(r - LROWS) * DM; mr = 8; }
    const f32x4* xr = (const f32x4*)src + lane; f32x4 v[4]; float s = 0.f;
#pragma unroll
    for (int j = 0; j < 4; ++j) { v[j] = xr[64 * j]; s += (v[j][0] * v[j][0] + v[j][1] * v[j][1]) + (v[j][2] * v[j][2] + v[j][3] * v[j][3]); }
    const float rstd = 1.0f / sqrtf(wave_sum(s) * (1.0f / DM) + NORM_EPS);
    const f32x4* md = (const f32x4*)(WSP(float, WS_MOD) + ((size_t)layer * 9 + mr) * 3072) + lane; const f32x4* g = (const f32x4*)(p.norm_g + layer * DM) + lane;
    u32x2* o = (u32x2*)(WSP(bf16_t, WS_H) + (size_t)r * DM) + lane;
#pragma unroll
    for (int j = 0; j < 4; ++j) { const f32x4 sh = md[64 * j], sc = md[256 + 64 * j], gg = g[64 * j]; const f32x4 y = v[j] * rstd * gg * (sc + 1.0f) + sh; o[64 * j] = (u32x2){pk2(y[0], y[1]), pk2(y[2], y[3])}; }
}
__device__ __forceinline__ void final_row(const Params& p, long r, int lane) {
    f32x4* xr = (f32x4*)(p.out + (size_t)r * DM) + lane; f32x4 v[4]; float s = 0.f;
#pragma unroll
    for (int j = 0; j < 4; ++j) { v[j] = xr[64 * j]; s += (v[j][0] * v[j][0] + v[j][1] * v[j][1]) + (v[j][2] * v[j][2] + v[j][3] * v[j][3]); }
    const float rstd = 1.0f / sqrtf(wave_sum(s) * (1.0f / DM) + NORM_EPS); const f32x4* g = (const f32x4*)p.final_g + lane;
#pragma unroll
    for (int j = 0; j < 4; ++j) xr[64 * j] = v[j] * rstd * g[64 * j];
}
constexpr int GM_PITCH = 136;
constexpr int GM_LDS = 64 * GM_PITCH * 2;
__device__ __forceinline__ void gmlp_unit(const Params& p, long r0, int g, char* shm) {
    int tid_ = tid_rebuilt(); asm volatile("" : "+v"(tid_));
    const int tid = tid_, lane = tid & 63, r32 = lane & 31, hi = lane >> 5; const int wid = __builtin_amdgcn_readfirstlane(tid >> 6);
    const bf16_t* P0 = WSP(bf16_t, WS_P0); bf16_t* vnT = (bf16_t*)shm;
#pragma unroll
    for (int rep = 0; rep < 2; ++rep) { const int item = tid + rep * 512, q = item >> 3, c8 = item & 7;
        const f32x4* pt = (const f32x4*)(WSP(float, WS_VVP) + (size_t)(r0 + q) * 16); const f32x4 a = pt[0], b = pt[1], c = pt[2], d = pt[3];
        const float sm = (a[0] + a[2]) + (b[0] + b[2]) + (c[0] + c[2]) + (d[0] + d[2]), sq = (a[1] + a[3]) + (b[1] + b[3]) + (c[1] + c[3]) + (d[1] + d[3]);
        const float mean = sm * (1.0f / 512), rstd = __builtin_amdgcn_rsqf(sq * (1.0f / 512) - mean * mean + NORM_EPS);
        const u32x4 raw = *(const u32x4*)(P0 + (size_t)(r0 + q) * N_IN0 + C_VV + 64 * g + 8 * c8);
        const f32x4 g0 = *(const f32x4*)(p.gm_ln_g + 64 * g + 8 * c8), g1 = *(const f32x4*)(p.gm_ln_g + 64 * g + 8 * c8 + 4);
        const f32x4 b0 = *(const f32x4*)(p.gm_ln_b + 64 * g + 8 * c8), b1 = *(const f32x4*)(p.gm_ln_b + 64 * g + 8 * c8 + 4);
#pragma unroll
        for (int k = 0; k < 4; ++k) { const float x0 = __uint_as_float(raw[k] << 16), x1 = __uint_as_float(raw[k] & 0xffff0000u);
            const float gg0 = k < 2 ? g0[2 * k] : g1[2 * k - 4], gg1 = k < 2 ? g0[2 * k + 1] : g1[2 * k - 3], bb0 = k < 2 ? b0[2 * k] : b1[2 * k - 4], bb1 = k < 2 ? b0[2 * k + 1] : b1[2 * k - 3];
            vnT[(8 * c8 + 2 * k) * GM_PITCH + q] = f2bf((x0 - mean) * rstd * gg0 + bb0); vnT[(8 * c8 + 2 * k + 1) * GM_PITCH + q] = f2bf((x1 - mean) * rstd * gg1 + bb1); } }
    __syncthreads();
    const int pb = wid & 3, cbk = wid >> 2;
    const bf16_t* wr_ = WSP(bf16_t, WS_WS) + ((size_t)g * 128 + 32 * pb + r32) * 128 + 8 * hi; const bf16_t* ar_ = vnT + (32 * cbk + r32) * GM_PITCH + 8 * hi;
    f32x16 acc = f32x16{};
#pragma unroll
    for (int ks = 0; ks < 8; ++ks) { const bf16x8 af = *(const bf16x8*)(ar_ + 16 * ks), bf = *(const bf16x8*)(wr_ + 16 * ks); acc = __builtin_amdgcn_mfma_f32_32x32x16_bf16(af, bf, acc, 0, 0, 0); }
    const long row = r0 + 32 * pb + r32; const float bs = p.gm_bs[g * 128 + 32 * pb + r32];
    const bf16_t* prow = P0 + (size_t)row * N_IN0; bf16_t* orow = WSP(bf16_t, WS_MIX) + (size_t)row * DM + 512;
#pragma unroll
    for (int g4 = 0; g4 < 4; ++g4) { const int cc = 64 * g + 32 * cbk + 8 * g4 + 4 * hi;
        const u32x2 uu = *(const u32x2*)(prow + C_U + cc), gt = *(const u32x2*)(prow + C_G + 512 + cc); u32x2 w;
#pragma unroll
        for (int k = 0; k < 2; ++k) { const float u0 = __uint_as_float(uu[k] << 16), u1 = __uint_as_float(uu[k] & 0xffff0000u), t0 = __uint_as_float(gt[k] << 16), t1 = __uint_as_float(gt[k] & 0xffff0000u);
            w[k] = pk2(u0 * (acc[4 * g4 + 2 * k] + bs) * t0, u1 * (acc[4 * g4 + 2 * k + 1] + bs) * t1); }
        *(u32x2*)(orow + cc) = w; }
    __syncthreads();
}
}
#define LAS __attribute__((address_space(3)))
#define XB_TMO      128
#define XB_XCNT(j)  (256  + 64 * (j))
#define XB_XSUB(j)  (1280 + 64 * (j))
#define XB_XGEN(j)  (2304 + 64 * (j))
#define XB_TOP      3328
#define XB_TOPGEN   3392
#define XCD_BAR_WORDS 3456
#define XB_SPIN_CAP (1u << 18)

__device__ __forceinline__ unsigned xb_ld(unsigned* p)              { return __hip_atomic_load(p, __ATOMIC_RELAXED, __HIP_MEMORY_SCOPE_AGENT); }
__device__ __forceinline__ unsigned xb_add(unsigned* p, unsigned v) { return __hip_atomic_fetch_add(p, v, __ATOMIC_RELAXED, __HIP_MEMORY_SCOPE_AGENT); }
__device__ __forceinline__ unsigned xb_xcc_id() { return (unsigned)__builtin_amdgcn_s_getreg((3 << 11) | 20) & 0xFu; }
#define XB_SPIN(cond, bar) do { unsigned _sp = 0; while (cond) { __builtin_amdgcn_s_sleep(1); \
    if ((++_sp & 255u) == 0u) { if (xb_ld(&(bar)[XB_TMO])) break; if (_sp > XB_SPIN_CAP) { atomicAdd(&(bar)[XB_TMO], 1u); break; } } } } while (0)

struct XcdBarrier {
    unsigned* bar; unsigned x;
    volatile LAS unsigned* st;
};

__device__ __forceinline__ XcdBarrier xcd_barrier_post(unsigned* bar, volatile LAS unsigned* st) {
    XcdBarrier b; b.bar = bar; b.x = xb_xcc_id(); b.st = st;
    if (threadIdx.x == 0) (void)xb_add(&bar[XB_XCNT(b.x)], 1u);
    return b;
}
__device__ __forceinline__ void xcd_barrier_complete(unsigned* bar, unsigned x, unsigned& nloc, unsigned& nx) {
    const unsigned G = gridDim.x * gridDim.y * gridDim.z;
    unsigned sum, cnt, mine, sp = 0u;
    for (;;) {
        sum = 0u; cnt = 0u; mine = 0u;
#pragma nounroll
        for (unsigned j = 0; j < 16; ++j) { const unsigned c = xb_ld(&bar[XB_XCNT(j)]); sum += c; cnt += (c > 0u) ? 1u : 0u; mine = (j == x) ? c : mine; }
        if (sum == G) break;
        __builtin_amdgcn_s_sleep(1);
        if ((++sp & 255u) == 0u) { if (xb_ld(&bar[XB_TMO])) break; if (sp > XB_SPIN_CAP) { atomicAdd(&bar[XB_TMO], 1u); break; } }
    }
    nloc = mine > 0u ? mine : 1u; nx = cnt > 0u ? cnt : 1u;
}

__device__ __forceinline__ void xcd_barrier(const XcdBarrier& b, bool leader_thread) {
    asm volatile("s_waitcnt vmcnt(0)" ::: "memory");
    __syncthreads();
    if (leader_thread) {
        unsigned* bar = b.bar;
        __builtin_amdgcn_s_waitcnt(0);
        unsigned nloc = b.st[0], nx = b.st[1];
        if (nloc == 0u) { xcd_barrier_complete(bar, b.x, nloc, nx); b.st[0] = nloc; b.st[1] = nx; }
        const unsigned old = xb_add(&bar[XB_XSUB(b.x)], 1u);
        const unsigned gen = old / nloc;
        if (old + 1u == (gen + 1u) * nloc) {
            __builtin_amdgcn_fence(__ATOMIC_RELEASE, "agent");
            asm volatile("s_waitcnt vmcnt(0)" ::: "memory");
            const unsigned og = xb_add(&bar[XB_TOP], 1u);
            const unsigned tg = og / nx;
            if (og + 1u == (tg + 1u) * nx) xb_add(&bar[XB_TOPGEN], 1u);
            else XB_SPIN(xb_ld(&bar[XB_TOPGEN]) == tg, bar);
            __builtin_amdgcn_fence(__ATOMIC_ACQUIRE, "agent");
            xb_add(&bar[XB_XGEN(b.x)], 1u);
            asm volatile("s_waitcnt vmcnt(0)" ::: "memory");
        } else {
            XB_SPIN(xb_ld(&bar[XB_XGEN(b.x)]) == gen, bar);
            __builtin_amdgcn_fence(__ATOMIC_ACQUIRE, "agent");
            asm volatile("s_waitcnt vmcnt(0)" ::: "memory");
        }
    }
    __syncthreads();
}
namespace cg = cooperative_groups;
constexpr int NTHREADS = 512, NWAVES = 8;
constexpr int LDS_BYTES = 147456;
static_assert(att::LDS_BYTES <= 131072 && thin::GM_LDS <= 131072 && NWAVES * 64 * 33 * 4 <= 131072, "LDS map");
#ifndef GSEL_IN0
#define GSEL_IN0 1
#endif
#ifndef GSEL_OUT0
#define GSEL_OUT0 1
#endif
#ifndef GSEL_IN1
#define GSEL_IN1 1
#endif
#ifndef GSEL_QB
#define GSEL_QB 1
#endif
#ifndef GSEL_KVB
#define GSEL_KVB 1
#endif
#ifndef GSEL_OUT1
#define GSEL_OUT1 1
#endif
#ifndef REP_NORM0
#define REP_NORM0 1
#endif
#ifndef REP_IN0
#define REP_IN0 1
#endif
#ifndef REP_ATT0
#define REP_ATT0 1
#endif
#ifndef REP_GMLP
#define REP_GMLP 1
#endif
#ifndef REP_OUT0
#define REP_OUT0 1
#endif
#ifndef REP_NORM1
#define REP_NORM1 1
#endif
#ifndef REP_IN1
#define REP_IN1 1
#endif
#ifndef REP_QB
#define REP_QB 1
#endif
#ifndef REP_KVB
#define REP_KVB 1
#endif
#ifndef REP_ATT1
#define REP_ATT1 1
#endif
#ifndef REP_SYNC
#define REP_SYNC 1
#endif
#ifndef PG8_SP2
#define PG8_SP2 true
#endif
#ifndef PG8_ALIGN
#define PG8_ALIGN true
#endif
#ifndef REP_S0
#define REP_S0 1
#endif
#ifndef REP_ALL
#define REP_ALL 1
#endif
#ifndef MLA_STAGGER
#define MLA_STAGGER false
#endif
#ifndef OPT_S0
#define OPT_S0 1
#endif
#ifndef OPT_NORM
#define OPT_NORM 1
#endif
#ifndef OPT_GEMM
#define OPT_GEMM 1
#endif
#ifndef OPT_ATT0
#define OPT_ATT0 1
#endif
#ifndef OPT_GMLP
#define OPT_GMLP 1
#endif
#ifndef OPT_ATT1
#define OPT_ATT1 1
#endif

template <int S> __device__ __forceinline__ void naive_stage(const Params& p) {
    const long n = stage_items(S);
    for (long it = (long)blockIdx.x * NTHREADS + threadIdx.x; it < n; it += (long)gridDim.x * NTHREADS) stage_item(p, S, it);
}
#define GRID_SYNC() do { for (int rs_ = 0; rs_ < REP_SYNC; ++rs_) xcd_barrier(bar, wid == 0 && lane_id() == 0); } while (0)
#define GRID_SYNC_CG() grid.sync()
#ifdef STAMP_A
#define STAMP() do { if (bid == 0 && wid == 0 && lane_id() == 0) { const Params ps_ = load_params(); ((unsigned long long*)(ps_.ws + WS_CTL + 32768))[nstamp] = __builtin_amdgcn_s_memrealtime(); } ++nstamp; } while (0)
#else
#define STAMP() do {} while (0)
#endif

__device__ __forceinline__ Params load_params() {
    Params r{};
#if defined(__HIP_DEVICE_COMPILE__)
    typedef const __attribute__((address_space(4))) unsigned long long* KP64;
    KP64 kp = (KP64)__builtin_amdgcn_kernarg_segment_ptr(); asm volatile("" : "+s"(kp));
    unsigned long long w[23];
#pragma unroll
    for (int i = 0; i < 23; ++i) w[i] = kp[i];
    r.x = (const float*)w[0]; r.c = (const float*)w[1]; r.ctx = (const float*)w[2]; r.c_ctx = (const float*)w[3]; r.norm_g = (const float*)w[4]; r.w_ada = (const float*)w[5]; r.b_ada = (const float*)w[6];
    r.w_in0 = (const float*)w[7]; r.sink0 = (const float*)w[8]; r.gm_ln_g = (const float*)w[9]; r.gm_ln_b = (const float*)w[10]; r.gm_ws = (const float*)w[11]; r.gm_bs = (const float*)w[12]; r.w_out0 = (const float*)w[13];
    r.w_in1 = (const float*)w[14]; r.q_norm = (const float*)w[15]; r.w_qb = (const float*)w[16]; r.kv_norm = (const float*)w[17]; r.w_kvb = (const float*)w[18]; r.w_out1 = (const float*)w[19]; r.final_g = (const float*)w[20];
    r.out = (float*)w[21]; r.ws = (unsigned char*)w[22];
#endif
    return r;
}
#define PHASE_BEGIN { const Params p = load_params(); bf16_t* const H = WSP(bf16_t, WS_H); bf16_t* const P0 = WSP(bf16_t, WS_P0); bf16_t* const MIX = WSP(bf16_t, WS_MIX); float* const MOD = WSP(float, WS_MOD); (void)H; (void)P0; (void)MIX; (void)MOD;
#define PHASE_END }
__global__ void __launch_bounds__(NTHREADS, 2) k_fwd(Params p_arg_unused) {
    extern __shared__ __attribute__((aligned(16))) unsigned char lds[];
    cg::grid_group grid = cg::this_grid();
    const int wid = __builtin_amdgcn_readfirstlane((int)threadIdx.x >> 6);
#define lane lane_id()
    volatile LAS unsigned* bst = (volatile LAS unsigned*)((LAS unsigned char*)lds + 131072 + 256);
    if (threadIdx.x < 2) bst[threadIdx.x] = 0u;
    __syncthreads();
    int nstamp = 0; (void)nstamp;
    XcdBarrier bar; { const Params p0_ = load_params(); bar = xcd_barrier_post((unsigned*)(p0_.ws + WS_CTL) + 1024, bst); }
    const int G = gridDim.x, bid = blockIdx.x, vcu = (G % 8 == 0) ? (bid % 8) * (G / 8) + bid / 8 : bid;
    PG8_LAS unsigned char* glds = (PG8_LAS unsigned char*)lds;

    STAMP();
    for (int pass_ = 0; pass_ < REP_ALL; ++pass_) {
    PHASE_BEGIN
#if OPT_S0
    { TH_LAS float* scr = (TH_LAS float*)lds + wid * (64 * 33);
      for (int it = vcu * NWAVES + wid; it < thin::WI_TOTAL; it += G * NWAVES) if (pass_ == 0 || it >= thin::WI_ADA) thin::stage0_item(p, it, scr, lane);
      for (int rep_ = 1; rep_ < REP_S0; ++rep_) for (int it = vcu * NWAVES + wid; it < thin::WI_TOTAL; it += G * NWAVES) if (it >= thin::WI_ADA) thin::stage0_item(p, it, scr, lane); }
#else
    naive_stage<0>(p); naive_stage<1>(p); naive_stage<2>(p);
#endif
    PHASE_END
    GRID_SYNC_CG(); STAMP();
    PHASE_BEGIN
#if OPT_NORM
    for (int rep_ = 0; rep_ < REP_NORM0; ++rep_) for (long r = (long)bid * NWAVES + wid; r < ROWS; r += (long)G * NWAVES) thin::modnorm_row(p, r, 0, lane);
#else
    naive_stage<3>(p);
#endif
    PHASE_END
    GRID_SYNC(); STAMP();
    PHASE_BEGIN
#if OPT_GEMM
#if GSEL_IN0
    for (int rep_ = 0; rep_ < REP_IN0; ++rep_) { pg8::Gemm g{H, WSP(bf16_t, WS_WIN0), ROWS, N_IN0, DM}; pg8::StaticOrder S; S.init(ROWS, N_IN0, G, bid);
      pg8::EpiIn0 E{P0, WSP(float, WS_ROPE0), WSP(float, WS_VVP)};
      pg8::gemm_phase<pg8::EpiIn0, pg8::StaticOrder, PG8_ALIGN, PG8_SP2>(glds, g, S, E); }
#endif
#else
    naive_stage<4>(p); GRID_SYNC(); naive_stage<5>(p);
#endif
    PHASE_END
    GRID_SYNC(); STAMP();
    PHASE_BEGIN
#if OPT_ATT0
    for (int rep_ = 0; rep_ < REP_ATT0; ++rep_) for (int u = vcu; u < NB * 64 + NB * 8; u += G) {
        att::Desc D; int b, h;
        if (u < NB * 64) { b = u >> 6; const int rem = u & 63, hk = rem >> 5, qb = (rem >> 2) & 7; h = hk * 4 + (rem & 3);
            const int q0 = qb * 256; int tl0 = q0 / 64 - 2; if (tl0 < 0) tl0 = 0; int tl1 = q0 / 64 + 5; if (tl1 > SEQ / 64 - 1) tl1 = SEQ / 64 - 1;
            D.qrow0 = b * SEQ + q0; D.lat_row0 = b * SEQ + 64 * tl0; D.ntl = tl1 - tl0 + 1; D.band_q0 = q0; D.band_k0 = 64 * tl0; }
        else { const int cu = u - NB * 64; b = cu >> 3; h = cu & 7; D.qrow0 = LROWS + b * CTX; D.lat_row0 = 0; D.ntl = 0; D.band_q0 = 0; D.band_k0 = 0; }
        D.ws = p.ws; D.qh = 128 * h; D.kh = 128 * (h >> 2); D.gh = 128 * h; D.ctx_row0 = LROWS + b * CTX; D.ntc = CTX / 64; D.sink = p.sink0[h] * LOG2E; D.has_sink = 1;
        if (u < NB * 64) att::unit<att::LayWin, 4, true, false>(D, (char*)lds); else att::unit<att::LayWin, 4, false, false>(D, (char*)lds);
    }
#else
    naive_stage<6>(p);
#endif
#if OPT_GMLP
    __syncthreads();
    for (int rep_ = 0; rep_ < REP_GMLP; ++rep_) for (int u = vcu; u < (ROWS / 128) * 8; u += G) thin::gmlp_unit(p, (long)(u >> 3) * 128, u & 7, (char*)lds);
#else
    naive_stage<7>(p);
#endif
    PHASE_END
    GRID_SYNC(); STAMP();
    PHASE_BEGIN
#if OPT_GEMM
#if GSEL_OUT0
    for (int rep_ = 0; rep_ < REP_OUT0; ++rep_) { pg8::Gemm g{MIX, WSP(bf16_t, WS_WOUT0), ROWS, DM, DM}; pg8::StaticOrder S; S.init(ROWS, DM, G, bid);
      pg8::EpiOut E{p.x, p.out, p.ctx, WSP(float, WS_X1C), MOD};
      pg8::gemm_phase<pg8::EpiOut, pg8::StaticOrder, PG8_ALIGN, PG8_SP2>(glds, g, S, E); }
#endif
#else
    naive_stage<8>(p);
#endif
    PHASE_END
    GRID_SYNC(); STAMP();
    PHASE_BEGIN
#if OPT_NORM
    for (int rep_ = 0; rep_ < REP_NORM1; ++rep_) for (long r = (long)bid * NWAVES + wid; r < ROWS; r += (long)G * NWAVES) thin::modnorm_row(p, r, 1, lane);
#else
    naive_stage<9>(p);
#endif
    PHASE_END
    GRID_SYNC(); STAMP();
    PHASE_BEGIN
#if OPT_GEMM
#if GSEL_IN1
    for (int rep_ = 0; rep_ < REP_IN1; ++rep_) { pg8::Gemm g{H, WSP(bf16_t, WS_WIN1), ROWS, N_IN1, DM}; pg8::ExtOrder S; S.init2(LROWS, N_IN1, G, bid, CROWS / 256, LROWS / 256, 1);
      pg8::EpiIn1 E{WSP(bf16_t, WS_QA), WSP(bf16_t, WS_KVA), WSP(bf16_t, WS_KPE), WSP(bf16_t, WS_G1), WSP(float, WS_QSP), WSP(float, WS_KVSP), WSP(float, WS_ROPE1)};
      pg8::gemm_phase<pg8::EpiIn1, pg8::ExtOrder, PG8_ALIGN, PG8_SP2>(glds, g, S, E); }
#endif
#else
    naive_stage<10>(p); GRID_SYNC(); naive_stage<11>(p);
#endif
    PHASE_END
    GRID_SYNC(); STAMP();
    PHASE_BEGIN
#if OPT_GEMM
#if GSEL_QB
    for (int rep_ = 0; rep_ < REP_QB; ++rep_) { pg8::Gemm g{WSP(bf16_t, WS_QA), WSP(bf16_t, WS_WQB), LROWS, 1536, 256}; pg8::StaticOrder S; S.init(LROWS, 1536, G, bid);
      pg8::EpiQb E{WSP(bf16_t, WS_Q1), WSP(float, WS_QSP), WSP(float, WS_ROPE1)};
      pg8::gemm_phase<pg8::EpiQb, pg8::StaticOrder, PG8_ALIGN, PG8_SP2>(glds, g, S, E); }
#endif
#if GSEL_KVB
    for (int rep_ = 0; rep_ < REP_KVB; ++rep_) { pg8::Gemm g{WSP(bf16_t, WS_KVA), WSP(bf16_t, WS_WKVB), ROWS, 2048, 256}; pg8::StaticOrder S; S.init(ROWS, 2048, G, (bid + G / 2) % G);
      pg8::EpiKvb E{WSP(bf16_t, WS_K1N), WSP(bf16_t, WS_V1), WSP(float, WS_KVSP)};
      pg8::gemm_phase<pg8::EpiKvb, pg8::StaticOrder, PG8_ALIGN, PG8_SP2>(glds, g, S, E); }
#endif
#else
    naive_stage<12>(p); naive_stage<13>(p);
#endif
    PHASE_END
    GRID_SYNC(); STAMP();
    PHASE_BEGIN
#if OPT_ATT1
    for (int rep_ = 0; rep_ < REP_ATT1; ++rep_) for (int u = vcu; u < NB * 16 * (SEQ / 256); u += G) {
        const int qb = u % (SEQ / 256), h = (u / (SEQ / 256)) & 15, b = u / (16 * (SEQ / 256)); att::Desc D;
        D.ws = p.ws; D.qh = 192 * h; D.kh = 128 * h; D.gh = 128 * h;
        D.qrow0 = b * SEQ + qb * 256; D.lat_row0 = b * SEQ; D.ntl = SEQ / 64; D.ctx_row0 = LROWS + b * CTX; D.ntc = CTX / 64; D.band_q0 = 0; D.band_k0 = 0; D.sink = 0.f; D.has_sink = 0;
        att::unit<att::LayMla, 6, false, MLA_STAGGER>(D, (char*)lds);
    }
#else
    naive_stage<14>(p);
#endif
    PHASE_END
    GRID_SYNC(); STAMP();
    PHASE_BEGIN
#if OPT_GEMM
#if GSEL_OUT1
    { pg8::Gemm g{MIX, WSP(bf16_t, WS_WOUT1), LROWS, DM, DM}; pg8::StaticOrder S; S.init(LROWS, DM, G, bid);
      pg8::EpiOut E{p.out, p.out, nullptr, nullptr, MOD + 9 * 3072};
      pg8::gemm_phase<pg8::EpiOut, pg8::StaticOrder, PG8_ALIGN, PG8_SP2>(glds, g, S, E); }
#endif
#else
    naive_stage<15>(p);
#endif
    PHASE_END
    GRID_SYNC(); STAMP();
    PHASE_BEGIN
#if OPT_NORM
    for (long r = (long)bid * NWAVES + wid; r < LROWS; r += (long)G * NWAVES) thin::final_row(p, r, lane);
#else
    naive_stage<16>(p);
#endif
    PHASE_END
    }
#ifdef STAMP_A
    GRID_SYNC(); STAMP();
    { const Params p = load_params(); const unsigned long long* ts = (const unsigned long long*)(p.ws + WS_CTL + 32768);
#ifdef ABL_DET
      const float dA = (float)(ts[STAMP_B + 1] - ts[STAMP_A]) * 1e-3f;
      for (long r = (long)bid * NWAVES + wid; r < LROWS; r += (long)G * NWAVES) { float* o = p.out + (size_t)r * DM; const float* xi = p.x + (size_t)r * DM; for (int c = lane_id(); c < DM; c += 64) o[c] = xi[c]; }
      GRID_SYNC();
#else
      const float dA = (float)(ts[STAMP_B + 1] - ts[STAMP_A]) * 1e-4f;
#endif
      if (bid == 0 && wid == 0 && lane_id() == 0) p.out[0] += dA; }
#endif
#undef lane
}

extern "C" void kernel_launch(void* const* d_in, const int* in_sizes, int n_in, void* d_out, int out_size, void* d_ws, size_t ws_size, hipStream_t stream) {
    if (n_in != 21 || ws_size < WS_END || out_size != LROWS * DM) { fprintf(stderr, "kernel_launch: unexpected sizes n_in %d out %d ws %zu (need %zu)\n", n_in, out_size, ws_size, (size_t)WS_END); return; }
    Params p{};
    const float** f = (const float**)&p;
    for (int i = 0; i < 21; ++i) f[i] = (const float*)d_in[i];
    p.out = (float*)d_out; p.ws = (unsigned char*)d_ws;
    static int grid_blocks = 0;
    if (!grid_blocks) {
        int dev = 0, cus = 0, per_cu = 0;
        hipGetDevice(&dev);
        hipDeviceGetAttribute(&cus, hipDeviceAttributeMultiprocessorCount, dev);
        if (hipFuncSetAttribute((const void*)k_fwd, hipFuncAttributeMaxDynamicSharedMemorySize, LDS_BYTES) != hipSuccess) fprintf(stderr, "kernel_launch: hipFuncSetAttribute(%d B dynamic LDS) failed\n", LDS_BYTES);
        hipOccupancyMaxActiveBlocksPerMultiprocessor(&per_cu, k_fwd, NTHREADS, LDS_BYTES);
        if (per_cu < 1) { fprintf(stderr, "kernel_launch: occupancy query says %d blocks/CU\n", per_cu); per_cu = 1; }
        grid_blocks = cus;
    }
    hipMemsetAsync((char*)d_ws + WS_MOD, 0, (size_t)2 * 9 * 3072 * 4, stream);
    hipMemsetAsync((char*)d_ws + WS_CTL, 0, 65536, stream);
    void* args[] = {&p};
    hipError_t e = hipLaunchCooperativeKernel((void*)k_fwd, dim3(grid_blocks), dim3(NTHREADS), args, LDS_BYTES, stream);
    if (e != hipSuccess) fprintf(stderr, "cooperative launch failed: %s (grid %d)\n", hipGetErrorString(e), grid_blocks);
}
#else
static std::vector<float> readf(const char* path, size_t n) { std::vector<float> v(n); FILE* f = fopen(path, "rb"); if (!f) { printf("cannot open %s\n", path); exit(1); } size_t g = fread(v.data(), 4, n, f); fclose(f); if (g != n) { printf("short read %s %zu/%zu\n", path, g, n); exit(1); } return v; }
static void cmp(const char* name, const float* a, const float* b, size_t n) { double e = 0, s = 0, mx = 0; for (size_t i = 0; i < n; ++i) { double d = (double)a[i] - b[i]; e += d * d; s += (double)b[i] * b[i]; if (fabs(d) > mx) mx = fabs(d); }
    printf("%-8s rvr %.3e  rel %.3e  absmax %.3e  (ref rms %.4f)\n", name, e / s, sqrt(e / s), mx, sqrt(s / n)); }
int main(int argc, char** argv) {
    const char* dir = argc > 1 ? argv[1] : "data"; char path[512];
    const size_t sizes[21] = {(size_t)LROWS * DM, (size_t)NB * DM, (size_t)CROWS * DM, DM, 2 * DM, 2u * DM * 3072, 2 * 3072, (size_t)DM * N_IN0, 8, 512, 512, 8 * 128 * 128, 8 * 128, (size_t)DM * DM,
                              (size_t)DM * 1440, 256, 256 * 1536, 128, 128 * 2048, (size_t)DM * DM, DM};
    size_t tot = 0; for (int i = 0; i < 21; ++i) tot += sizes[i];
    snprintf(path, sizeof path, "%s/inputs.bin", dir); std::vector<float> in = readf(path, tot);
    Params p{}; const float** f = (const float**)&p; size_t off = 0; for (int i = 0; i < 21; ++i) { f[i] = in.data() + off; off += sizes[i]; }
    std::vector<float> out((size_t)LROWS * DM, NAN); std::vector<unsigned char> ws(WS_END, 0xAA); p.out = out.data(); p.ws = ws.data();
    auto dump_bf = [&](const char* nm, size_t wsoff, size_t rows, size_t pitch, size_t c0, size_t ncol, float scale) {
        snprintf(path, sizeof path, "%s/dbg_%s.bin", dir, nm); std::vector<float> ref = readf(path, rows * ncol); std::vector<float> mine(rows * ncol);
        const bf16_t* b = (const bf16_t*)(ws.data() + wsoff); for (size_t r = 0; r < rows; ++r) for (size_t c = 0; c < ncol; ++c) mine[r * ncol + c] = bf2f(b[r * pitch + c0 + c]) * scale; cmp(nm, mine.data(), ref.data(), rows * ncol); };
    for (int s = 0; s <= N_STAGES; ++s) {
        long n = stage_items(s);
#pragma omp parallel for schedule(dynamic, 256)
        for (long it = 0; it < n; ++it) stage_item(p, s, it);
        if (s == 3) {
            snprintf(path, sizeof path, "%s/dbg_h0.bin", dir); std::vector<float> ref = readf(path, (size_t)ROWS * DM); std::vector<float> mine((size_t)ROWS * DM); const bf16_t* H = (const bf16_t*)(ws.data() + WS_H);
            for (int b = 0; b < NB; ++b) for (int j = 0; j < SEQ + CTX; ++j) { size_t r = j < SEQ ? (size_t)b * SEQ + j : LROWS + (size_t)b * CTX + j - SEQ; for (int c = 0; c < DM; ++c) mine[((size_t)b * (SEQ + CTX) + j) * DM + c] = bf2f(H[r * DM + c]); }
            cmp("h0", mine.data(), ref.data(), mine.size()); }
        if (s == 4) { dump_bf("q0", WS_P0, LROWS, N_IN0, C_Q, 512, 1.0f / QSCALE0); dump_bf("k0", WS_P0, LROWS, N_IN0, C_K, 128, 1.0f); }
        if (s == 7) { snprintf(path, sizeof path, "%s/dbg_mix0.bin", dir); std::vector<float> ref = readf(path, (size_t)ROWS * DM); std::vector<float> mine((size_t)ROWS * DM); const bf16_t* H = (const bf16_t*)(ws.data() + WS_MIX);
            for (int b = 0; b < NB; ++b) for (int j = 0; j < SEQ + CTX; ++j) { size_t r = j < SEQ ? (size_t)b * SEQ + j : LROWS + (size_t)b * CTX + j - SEQ; for (int c = 0; c < DM; ++c) mine[((size_t)b * (SEQ + CTX) + j) * DM + c] = bf2f(H[r * DM + c]); }
            cmp("mix0", mine.data(), ref.data(), mine.size()); }
        if (s == 8) { snprintf(path, sizeof path, "%s/dbg_x1.bin", dir); std::vector<float> ref = readf(path, (size_t)LROWS * DM); cmp("x1", out.data(), ref.data(), ref.size()); }
        if (s == 9) { snprintf(path, sizeof path, "%s/dbg_h1.bin", dir); std::vector<float> ref = readf(path, (size_t)ROWS * DM); std::vector<float> mine((size_t)ROWS * DM); const bf16_t* H = (const bf16_t*)(ws.data() + WS_H);
            for (int b = 0; b < NB; ++b) for (int j = 0; j < SEQ + CTX; ++j) { size_t r = j < SEQ ? (size_t)b * SEQ + j : LROWS + (size_t)b * CTX + j - SEQ; for (int c = 0; c < DM; ++c) mine[((size_t)b * (SEQ + CTX) + j) * DM + c] = bf2f(H[r * DM + c]); }
            cmp("h1", mine.data(), ref.data(), mine.size()); }
        if (s == 12) {
            snprintf(path, sizeof path, "%s/dbg_q1.bin", dir); std::vector<float> ref = readf(path, (size_t)LROWS * 1536); std::vector<float> mine((size_t)LROWS * 1536); const bf16_t* Q = (const bf16_t*)(ws.data() + WS_Q1);
            for (size_t r = 0; r < (size_t)LROWS; ++r) for (int c = 0; c < 1536; ++c) { int h = c / 96, w = c % 96; int oc = h * 96 + (w < 64 ? w : 64 + pe_orig(w - 64)); mine[r * 1536 + oc] = bf2f(Q[r * 1536 + c]) / QSCALE1; }
            cmp("q1", mine.data(), ref.data(), mine.size()); }
        if (s == 15) { snprintf(path, sizeof path, "%s/dbg_x2.bin", dir); std::vector<float> ref = readf(path, (size_t)LROWS * DM); cmp("x2", out.data(), ref.data(), ref.size()); }
    }
    snprintf(path, sizeof path, "%s/out.bin", dir); std::vector<float> ref = readf(path, (size_t)LROWS * DM); cmp("out", out.data(), ref.data(), ref.size());
    return 0;
}
#endif
```
